# Optimizing an MI355X kernel written in HIP

```python
import math
import jax, jax.numpy as jnp
from jax import lax
import numpy as np

D_MODEL = 1024
BATCH = 4
SEQ = 4096
DEPTH = 4

HEAD_DIM = 64
MIX_WIDTH = D_MODEL
GROUP_WIDTH = MIX_WIDTH // 4
CONV_WIDTH = 3
POOL_WINDOWS = (2, 4, 8, 16)
POOL_GROUP = GROUP_WIDTH // len(POOL_WINDOWS)
DSA_HEADS = GROUP_WIDTH // HEAD_DIM
IDX_HEADS = 8
IDX_DIM = 64
DSA_TOPK_MAX = 256
MOBA_HEADS = GROUP_WIDTH // HEAD_DIM
MOBA_BLOCK = 256
MOBA_TOPB_MAX = 3
REL_BUCKETS = 32
REL_MAX_DIST = 128
N_ATTN_HEADS = DSA_HEADS + MOBA_HEADS
D_FF = -(-8 * D_MODEL // (3 * 256)) * 256
PLE_DIM = 256
Q_BLOCK = 128
MOBA_Q_BLOCK = 64
RMS_EPS = 1e-6
SPLIT_SIZES = (GROUP_WIDTH, GROUP_WIDTH, GROUP_WIDTH,
               GROUP_WIDTH,
               GROUP_WIDTH, GROUP_WIDTH, GROUP_WIDTH, IDX_HEADS * IDX_DIM, IDX_DIM, IDX_HEADS,
               GROUP_WIDTH, GROUP_WIDTH, GROUP_WIDTH)
IN_COLS = sum(SPLIT_SIZES)

kernel_name = "hybrid_conv_pool_dsa_moba_trunk"


def rmsnorm(x, g):
    x32 = x.astype(jnp.float32)
    y = x32 * lax.rsqrt(jnp.mean(x32 * x32, axis=-1, keepdims=True) + RMS_EPS)
    return (y * g.astype(jnp.float32)).astype(x.dtype)


def rel_bucket(dist):
    n = jnp.maximum(dist, 0)
    max_exact = REL_BUCKETS // 2
    nf = jnp.maximum(n, 1).astype(jnp.float32)
    large = max_exact + (jnp.log(nf / max_exact) / math.log(REL_MAX_DIST / max_exact)
                         * (REL_BUCKETS - max_exact)).astype(jnp.int32)
    large = jnp.minimum(large, REL_BUCKETS - 1)
    return jnp.where(n < max_exact, n, large)


def short_conv_mixer(a_in, gate_c, gate_b, conv_w):
    h = gate_c * a_in
    y = lax.conv_general_dilated(h, conv_w[:, None, :].astype(h.dtype), window_strides=(1,),
                                 padding=[(CONV_WIDTH - 1, 0)],
                                 dimension_numbers=("NWC", "WIO", "NWC"),
                                 feature_group_count=h.shape[-1])
    return gate_b * y


def pool_mixer(v, pool_w, pool_scale):
    b, s, _ = v.shape
    v32 = v.astype(jnp.float32)
    cs = jnp.concatenate([jnp.zeros((b, 1, GROUP_WIDTH), jnp.float32), lax.cumsum(v32, axis=1)], axis=1)
    t = jnp.arange(s)
    outs = []
    for g, w in enumerate(POOL_WINDOWS):
        sl = slice(g * POOL_GROUP, (g + 1) * POOL_GROUP)
        c = cs[:, :, sl]
        upper = c[:, 1:]
        lower = jnp.concatenate([jnp.zeros((b, w - 1, POOL_GROUP), jnp.float32), c[:, :s + 1 - w]], axis=1)
        cnt = jnp.minimum(t + 1, w).astype(jnp.float32)[None, :, None]
        outs.append((upper - lower) / cnt - v32[:, :, sl])
    d = jnp.stack(outs, axis=2)
    y = jnp.einsum("bsgc,gcd->bsgd", d, pool_w.astype(jnp.float32)).reshape(b, s, GROUP_WIDTH)
    return (y * pool_scale.astype(jnp.float32)).astype(v.dtype)


def dsa_mixer(q, k, v, iq, ik, iw, bias_tab):
    b, s, nh, hd = q.shape
    topk = min(DSA_TOPK_MAX, s // 4)
    idx_scale = (IDX_HEADS ** -0.5) * (IDX_DIM ** -0.5)
    ik32 = ik.astype(jnp.float32)
    bidx = jnp.arange(b)[:, None, None]
    spos = jnp.arange(s)

    def chunk(c):
        t0 = c * Q_BLOCK
        tq = t0 + jnp.arange(Q_BLOCK)
        qc = lax.dynamic_slice_in_dim(q, t0, Q_BLOCK, axis=1).astype(jnp.float32)
        iqc = lax.dynamic_slice_in_dim(iq, t0, Q_BLOCK, axis=1).astype(jnp.float32)
        iwc = lax.dynamic_slice_in_dim(iw, t0, Q_BLOCK, axis=1).astype(jnp.float32)
        sc = jax.nn.relu(jnp.einsum("bqhd,bsd->bqhs", iqc, ik32))
        score = jnp.einsum("bqh,bqhs->bqs", iwc, sc) * idx_scale
        score = jnp.where(spos[None, None, :] <= tq[None, :, None], score, -jnp.inf)
        _, sel = lax.top_k(score, topk)
        valid = sel <= tq[None, :, None]
        kg = k[bidx, sel].astype(jnp.float32)
        vg = v[bidx, sel].astype(jnp.float32)
        logits = jnp.einsum("bqhd,bqkhd->bhqk", qc, kg) * (hd ** -0.5)
        bias = jnp.moveaxis(bias_tab.astype(jnp.float32)[:, rel_bucket(tq[None, :, None] - sel)], 0, 1)
        logits = jnp.where(valid[:, None], logits + bias, -jnp.inf)
        probs = jax.nn.softmax(logits, axis=-1)
        return jnp.einsum("bhqk,bqkhd->bqhd", probs, vg)

    out = lax.map(chunk, jnp.arange(s // Q_BLOCK))
    return out.transpose(1, 0, 2, 3, 4).reshape(b, s, nh * hd).astype(q.dtype)


def moba_mixer(q, k, v, bias_tab):
    b, s, nh, hd = q.shape
    nb = -(-s // MOBA_BLOCK)
    pad = nb * MOBA_BLOCK - s
    kp = jnp.pad(k, ((0, 0), (0, pad), (0, 0), (0, 0)))
    vp = jnp.pad(v, ((0, 0), (0, pad), (0, 0), (0, 0)))
    kblk = kp.reshape(b, nb, MOBA_BLOCK, nh, hd)
    kmean = jnp.mean(kblk.astype(jnp.float32), axis=2)
    kblk_t = kblk.transpose(0, 3, 1, 2, 4)
    vblk_t = vp.reshape(b, nb, MOBA_BLOCK, nh, hd).transpose(0, 3, 1, 2, 4)
    topb = min(MOBA_TOPB_MAX, nb - 1)
    scale = hd ** -0.5
    tab = bias_tab.astype(jnp.float32)
    bi = jnp.arange(b)[:, None, None, None]
    hi = jnp.arange(nh)[None, :, None, None]
    blk_off = jnp.arange(MOBA_BLOCK)

    def chunk(c):
        t0 = c * MOBA_Q_BLOCK
        tq = t0 + jnp.arange(MOBA_Q_BLOCK)
        ob = t0 // MOBA_BLOCK
        qc = lax.dynamic_slice_in_dim(q, t0, MOBA_Q_BLOCK, axis=1).astype(jnp.float32)
        ko = lax.dynamic_slice_in_dim(kp, ob * MOBA_BLOCK, MOBA_BLOCK, axis=1).astype(jnp.float32)
        vo = lax.dynamic_slice_in_dim(vp, ob * MOBA_BLOCK, MOBA_BLOCK, axis=1).astype(jnp.float32)
        spos_o = ob * MOBA_BLOCK + blk_off
        lo = jnp.einsum("bqhd,bshd->bhqs", qc, ko) * scale + tab[:, rel_bucket(tq[:, None] - spos_o[None, :])][None]
        lo = jnp.where((spos_o[None, :] <= tq[:, None])[None, None], lo, -jnp.inf)
        if topb == 0:
            po = jax.nn.softmax(lo, axis=-1)
            return jnp.einsum("bhqs,bshd->bqhd", po, vo)
        gate = jnp.einsum("bqhd,bnhd->bhqn", qc, kmean)
        gate = jnp.where(jnp.arange(nb)[None, None, None, :] < ob, gate, -jnp.inf)
        _, sel = lax.top_k(gate, topb)
        valid = sel < ob
        kg = kblk_t[bi, hi, sel].astype(jnp.float32)
        vg = vblk_t[bi, hi, sel].astype(jnp.float32)
        lp = jnp.einsum("bqhd,bhqnsd->bhqns", qc, kg) * scale
        spos_p = sel[..., None] * MOBA_BLOCK + blk_off
        lp = lp + tab[hi[..., None], rel_bucket(tq[None, None, :, None, None] - spos_p)]
        lp = jnp.where(valid[..., None], lp, -jnp.inf)
        npast = topb * MOBA_BLOCK
        logits = jnp.concatenate([lp.reshape(b, nh, MOBA_Q_BLOCK, npast), lo], axis=-1)
        probs = jax.nn.softmax(logits, axis=-1)
        pp = probs[..., :npast].reshape(b, nh, MOBA_Q_BLOCK, topb, MOBA_BLOCK)
        po = probs[..., npast:]
        return (jnp.einsum("bhqns,bhqnsd->bqhd", pp, vg) + jnp.einsum("bhqs,bshd->bqhd", po, vo))

    out = lax.map(chunk, jnp.arange(s // MOBA_Q_BLOCK))
    return out.transpose(1, 0, 2, 3, 4).reshape(b, s, nh * hd).astype(q.dtype)


def swiglu(h, w_gate_up, w_down):
    gu = h @ w_gate_up
    gate, up = jnp.split(gu, 2, axis=-1)
    return (jax.nn.silu(gate) * up) @ w_down


def setup_inputs(seed: int = 0) -> dict:
    key = jax.random.key(seed)
    ks = jax.random.split(key, 20)
    f32 = jnp.float32

    def nrm(k, shape, scale):
        return jax.random.normal(k, shape, f32) * scale

    def gain(k, shape):
        return 1.0 + 0.05 * jax.random.normal(k, shape, f32)

    return {
        "x": nrm(ks[0], (BATCH, SEQ, D_MODEL), 1.0),
        "p": nrm(ks[1], (DEPTH, BATCH, SEQ, PLE_DIM), 1.0),
        "rel_bias": nrm(ks[2], (N_ATTN_HEADS, REL_BUCKETS), 0.5),
        "g_mix_pre": gain(ks[3], (DEPTH, D_MODEL)),
        "w_in": nrm(ks[4], (DEPTH, D_MODEL, IN_COLS), D_MODEL ** -0.5),
        "conv_w": nrm(ks[5], (DEPTH, CONV_WIDTH, GROUP_WIDTH), CONV_WIDTH ** -0.5),
        "pool_w": nrm(ks[6], (DEPTH, len(POOL_WINDOWS), POOL_GROUP, POOL_GROUP), POOL_GROUP ** -0.5),
        "pool_scale": gain(ks[7], (DEPTH, GROUP_WIDTH)),
        "w_out": nrm(ks[8], (DEPTH, MIX_WIDTH, D_MODEL), MIX_WIDTH ** -0.5),
        "g_mix_post": gain(ks[9], (DEPTH, D_MODEL)),
        "g_ffn_pre": gain(ks[10], (DEPTH, D_MODEL)),
        "w_gate_up": nrm(ks[11], (DEPTH, D_MODEL, 2 * D_FF), D_MODEL ** -0.5),
        "w_down": nrm(ks[12], (DEPTH, D_FF, D_MODEL), D_FF ** -0.5),
        "g_ffn_post": gain(ks[13], (DEPTH, D_MODEL)),
        "g_ple": gain(ks[14], (DEPTH, D_MODEL)),
        "w_ple_gate": nrm(ks[15], (DEPTH, D_MODEL, D_MODEL), D_MODEL ** -0.5),
        "w_ple_proj": nrm(ks[16], (DEPTH, PLE_DIM, D_MODEL), PLE_DIM ** -0.5),
    }


def reference(x, p, rel_bias, g_mix_pre, w_in, conv_w, pool_w, pool_scale, w_out, g_mix_post,
              g_ffn_pre, w_gate_up, w_down, g_ffn_post, g_ple, w_ple_gate, w_ple_proj):
    b, s, _ = x.shape
    split_at = tuple(int(o) for o in np.cumsum(SPLIT_SIZES)[:-1])

    def heads(t):
        return t.reshape(b, s, -1, HEAD_DIM)

    for i in range(DEPTH):
        h = rmsnorm(x, g_mix_pre[i])
        z = h @ w_in[i]
        (a_in, a_c, a_b, pv, cq, ck, cv, iq, ik, iw, dq, dk, dv) = jnp.split(z, split_at, axis=-1)
        ya = short_conv_mixer(a_in, a_c, a_b, conv_w[i])
        yb = pool_mixer(pv, pool_w[i], pool_scale[i])
        yc = dsa_mixer(heads(cq), heads(ck), heads(cv), iq.reshape(b, s, IDX_HEADS, IDX_DIM), ik, iw,
                       rel_bias[:DSA_HEADS])
        yd = moba_mixer(heads(dq), heads(dk), heads(dv), rel_bias[DSA_HEADS:])
        mix = jnp.concatenate([ya, yb, yc, yd], axis=-1) @ w_out[i]
        x = x + rmsnorm(mix, g_mix_post[i])
        f = swiglu(rmsnorm(x, g_ffn_pre[i]), w_gate_up[i], w_down[i])
        x = x + rmsnorm(f, g_ffn_post[i])
        gate = jax.nn.sigmoid(rmsnorm(x, g_ple[i]) @ w_ple_gate[i])
        x = x + gate * (p[i] @ w_ple_proj[i])
    return x
```

```cpp
#include <hip/hip_runtime.h>
#include <cstdio>
#include <cstdint>
namespace pg8 {
#define PG8_LAS __attribute__((address_space(3)))
typedef unsigned short bf16_t;
typedef short bf16x8 __attribute__((ext_vector_type(8)));
typedef float f32x4 __attribute__((ext_vector_type(4)));
typedef unsigned u32x4 __attribute__((ext_vector_type(4)));
constexpr int BM = 256, BK = 64, HALF = 128, HTB = HALF * BK * 2  , STAGE_BYTES = 8 * HTB, NXCD = 8, WGM = 8;

__host__ __device__ __forceinline__ int lds_byte(int r, int c) { const int st = (r >> 4) * 2 + (c >> 5), rr = r & 15, cc = c & 31, ob = rr * 64 + cc * 2; return st * 1024 + (ob ^ (((ob >> 9) & 1) << 5)); }
__host__ __device__ __forceinline__ void stage_rc(int b, int& R, int& C) { const int st = b / 1024, sb = b % 1024, swz = sb ^ (((sb >> 9) & 1) << 5); R = (st >> 1) * 16 + swz / 64; C = (st & 1) * 32 + (swz % 64) / 2; }
__host__ __device__ __forceinline__ int perm32(int rho) { const int n = rho >> 4, i = rho & 15; return 8 * (i >> 2) + 4 * n + (i & 3); }

struct Unit { int pm, pn; };
struct Gemm { const bf16_t* A; const bf16_t* Bt; int M, N, K; };

struct StaticOrder {
    int nM, nN, nwg, G, c;
    __host__ __device__ void init(int M, int N, int G_, int c_) { nM = M / BM; nN = N / BM; nwg = nM * nN; G = G_; c = c_; }
    __host__ __device__ bool next(int i, Unit& u) const {
        const long L = (long)i * G + c; if (L >= nwg) return false;
        int wgid = (int)L; { const int q = nwg / NXCD, r = nwg % NXCD, xcd = wgid % NXCD, off = wgid / NXCD; wgid = (xcd < r ? xcd * (q + 1) : r * (q + 1) + (xcd - r) * q) + off; }
        const int nig = WGM * nN, gid = wgid / nig, fm = gid * WGM, gsz = (nM - fm) < WGM ? (nM - fm) : WGM;
        u.pm = fm + ((wgid % nig) % gsz); u.pn = (wgid % nig) / gsz; return true;
    }
    __device__ __forceinline__ void a_ready(const Unit&) const {}
    __device__ __forceinline__ void done(const Unit&) const {}
};

template <class Epi, class Sched, bool ALIGN_EPI = false, bool SP2 = false>
__device__ __forceinline__ void gemm_phase(PG8_LAS unsigned char* lds, const Gemm g, const Sched& S, const Epi& E, int tid_in) {
    int tid_l = tid_in; asm volatile("" : "+v"(tid_l)); const int tid = tid_l, wid = __builtin_amdgcn_readfirstlane(tid >> 6), lane = tid & 63, wr = wid >> 2, wc = wid & 3, fr = lane & 15, fq = lane >> 4;
    const int K = g.K, nt = K / BK;
    unsigned voffA[2], voffB[2];
#pragma unroll
    for (int i = 0; i < 2; ++i) { int R, C; stage_rc(tid * 16 + i * 8192, R, C); const int Rb = Epi::PERM ? ((R & ~31) + perm32(R & 31)) : R;
        voffA[i] = (unsigned)(R * K + C) * 2u; voffB[i] = (unsigned)(Rb * K + C) * 2u; }
    const size_t kstep = (size_t)(BK * 2);
    const size_t hstep = (size_t)HALF * K * 2;
    const size_t tstep = 2 * hstep;
    const unsigned ldsw = (unsigned)wid * 1024u;
    const int aoff = lds_byte(wr * 64 + fr, fq * 8), boff = lds_byte(wc * 32 + fr, fq * 8);
#define PG8_SA(b, h) (((b) * 2 + (h)) * HTB)
#define PG8_SB(b, h) ((4 + (b) * 2 + (h)) * HTB)
#define PG8_STAGE(bufoff, gbase, voff) do { _Pragma("unroll") for (int _i = 0; _i < 2; ++_i) \
        __builtin_amdgcn_global_load_lds((const unsigned*)((const char*)(gbase) + (voff)[_i]), (PG8_LAS unsigned*)(lds + (bufoff) + ldsw + _i * 8192), 16, 0, 0); } while (0)
#define PG8_LDA(dst, b, h) do { _Pragma("unroll") for (int m = 0; m < 4; ++m) _Pragma("unroll") for (int k = 0; k < 2; ++k) dst[m][k] = *(const PG8_LAS bf16x8*)(lds + PG8_SA(b, h) + aoff + m * 2048 + k * 1024); } while (0)
#define PG8_LDB(dst, b, h) do { _Pragma("unroll") for (int n = 0; n < 2; ++n) _Pragma("unroll") for (int k = 0; k < 2; ++k) dst[n][k] = *(const PG8_LAS bf16x8*)(lds + PG8_SB(b, h) + boff + n * 2048 + k * 1024); } while (0)
#define PG8_MMA(ai, bj, At, Bt) do { __builtin_amdgcn_s_setprio(1); _Pragma("unroll") for (int m = 0; m < 4; ++m) _Pragma("unroll") for (int n = 0; n < 2; ++n) _Pragma("unroll") for (int k = 0; k < 2; ++k) \
        acc[ai][bj][m][n] = __builtin_amdgcn_mfma_f32_16x16x32_bf16(Bt[n][k], At[m][k], acc[ai][bj][m][n], 0, 0, 0); __builtin_amdgcn_s_setprio(0); } while (0)
#define PG8_WAIT_V(n) asm volatile("s_waitcnt vmcnt(" #n ")" ::: "memory")
#define PG8_WAIT_L(n) asm volatile("s_waitcnt lgkmcnt(" #n ")" ::: "memory")
#define PG8_BAR __builtin_amdgcn_s_barrier()
#define PG8_SCHED __builtin_amdgcn_sched_barrier(0)
    Unit cur, nxt; int ui = 0;
    if (!S.next(0, cur)) return;
    f32x4 acc[2][2][4][2];
#pragma unroll
    for (int a = 0; a < 2; ++a)
#pragma unroll
        for (int b = 0; b < 2; ++b)
#pragma unroll
            for (int m = 0; m < 4; ++m)
#pragma unroll
                for (int n = 0; n < 2; ++n) acc[a][b][m][n] = (f32x4){0.f, 0.f, 0.f, 0.f};
    bf16x8 At[4][2], B0[2][2], B1[2][2];
    const char* cA = (const char*)g.A + (size_t)cur.pm * tstep; const char* cB = (const char*)g.Bt + (size_t)cur.pn * tstep;
    S.a_ready(cur);
    if constexpr (SP2) {
        PG8_STAGE(PG8_SB(0, 0), cB, voffB); PG8_STAGE(PG8_SB(0, 1), cB + hstep, voffB); PG8_STAGE(PG8_SA(0, 0), cA, voffA); PG8_STAGE(PG8_SA(0, 1), cA + hstep, voffA);
        if (wr == 1) PG8_BAR;
        PG8_WAIT_V(2); PG8_BAR;
        PG8_STAGE(PG8_SB(1, 0), cB + kstep, voffB); PG8_STAGE(PG8_SA(1, 0), cA + kstep, voffA); PG8_STAGE(PG8_SB(1, 1), cB + hstep + kstep, voffB);
        PG8_WAIT_V(6); PG8_BAR;
    } else {
        PG8_STAGE(PG8_SB(0, 0), cB, voffB); PG8_STAGE(PG8_SA(0, 0), cA, voffA); PG8_STAGE(PG8_SB(0, 1), cB + hstep, voffB); PG8_STAGE(PG8_SA(0, 1), cA + hstep, voffA);
        if (wr == 1) PG8_BAR;
        PG8_WAIT_V(4); PG8_BAR;
        PG8_STAGE(PG8_SB(1, 0), cB + kstep, voffB); PG8_STAGE(PG8_SA(1, 0), cA + kstep, voffA); PG8_STAGE(PG8_SB(1, 1), cB + hstep + kstep, voffB);
        PG8_WAIT_V(6); PG8_BAR;
    }
    for (;;) {
        const bool has_next = S.next(ui + 1, nxt);
        const char* nA = has_next ? (const char*)g.A + (size_t)nxt.pm * tstep : cA; const char* nB = has_next ? (const char*)g.Bt + (size_t)nxt.pn * tstep : cB;
        for (int t = 0; t < nt; t += 2) {
            const bool last = (t == nt - 2);
            const char* a1 = cA + (size_t)(t + 1) * kstep;
            const char* a2 = last ? nA : cA + (size_t)(t + 2) * kstep; const char* b2 = last ? nB : cB + (size_t)(t + 2) * kstep;
            const char* a3 = a2 + kstep; const char* b3 = b2 + kstep;
            if (last && has_next) S.a_ready(nxt);
            if constexpr (SP2) {
            PG8_LDB(B0, 0, 0); PG8_LDB(B1, 0, 1); PG8_SCHED; PG8_LDA(At, 0, 0); PG8_STAGE(PG8_SA(1, 1), a1 + hstep, voffA);
            PG8_WAIT_V(8); PG8_WAIT_L(0); PG8_BAR; PG8_MMA(0, 0, At, B0); PG8_MMA(0, 1, At, B1); PG8_BAR; PG8_SCHED;
            PG8_LDA(At, 0, 1); PG8_STAGE(PG8_SB(0, 0), b2, voffB); PG8_STAGE(PG8_SB(0, 1), b2 + hstep, voffB); PG8_STAGE(PG8_SA(0, 0), a2, voffA);
            PG8_WAIT_V(8); PG8_WAIT_L(0); PG8_BAR; PG8_MMA(1, 0, At, B0); PG8_MMA(1, 1, At, B1); PG8_BAR; PG8_SCHED;
            PG8_LDB(B0, 1, 0); PG8_LDB(B1, 1, 1); PG8_SCHED; PG8_LDA(At, 1, 0); PG8_STAGE(PG8_SA(0, 1), a2 + hstep, voffA);
            PG8_WAIT_V(8); PG8_WAIT_L(0); PG8_BAR; PG8_MMA(0, 0, At, B0); PG8_MMA(0, 1, At, B1); PG8_BAR; PG8_SCHED;
            PG8_LDA(At, 1, 1); PG8_STAGE(PG8_SB(1, 0), b3, voffB); PG8_STAGE(PG8_SB(1, 1), b3 + hstep, voffB); PG8_STAGE(PG8_SA(1, 0), a3, voffA);
            PG8_WAIT_V(8); PG8_WAIT_L(0); PG8_BAR; PG8_MMA(1, 0, At, B0); PG8_MMA(1, 1, At, B1); PG8_BAR; PG8_SCHED;
            } else {
            PG8_LDB(B0, 0, 0); PG8_SCHED; PG8_LDA(At, 0, 0); PG8_STAGE(PG8_SA(1, 1), a1 + hstep, voffA);
            PG8_WAIT_L(8); PG8_BAR; PG8_WAIT_L(0); PG8_MMA(0, 0, At, B0); PG8_BAR; PG8_SCHED;
            PG8_LDB(B1, 0, 1); PG8_STAGE(PG8_SB(0, 0), b2, voffB);
            PG8_BAR; PG8_WAIT_L(0); PG8_MMA(0, 1, At, B1); PG8_BAR;
            PG8_LDA(At, 0, 1); PG8_STAGE(PG8_SA(0, 0), a2, voffA);
            PG8_BAR; PG8_WAIT_L(0); PG8_MMA(1, 0, At, B0); PG8_BAR; PG8_SCHED;
            PG8_STAGE(PG8_SB(0, 1), b2 + hstep, voffB);
            PG8_WAIT_V(6); PG8_BAR; PG8_MMA(1, 1, At, B1); PG8_BAR;
            PG8_LDB(B0, 1, 0); PG8_SCHED; PG8_LDA(At, 1, 0); PG8_STAGE(PG8_SA(0, 1), a2 + hstep, voffA);
            PG8_WAIT_L(8); PG8_BAR; PG8_WAIT_L(0); PG8_MMA(0, 0, At, B0); PG8_BAR; PG8_SCHED;
            PG8_LDB(B1, 1, 1); PG8_STAGE(PG8_SB(1, 0), b3, voffB);
            PG8_BAR; PG8_WAIT_L(0); PG8_MMA(0, 1, At, B1); PG8_BAR;
            PG8_LDA(At, 1, 1); PG8_STAGE(PG8_SA(1, 0), a3, voffA);
            PG8_BAR; PG8_WAIT_L(0); PG8_MMA(1, 0, At, B0); PG8_BAR; PG8_SCHED;
            PG8_STAGE(PG8_SB(1, 1), b3 + hstep, voffB);
            PG8_WAIT_V(6); PG8_BAR; PG8_MMA(1, 1, At, B1); PG8_BAR;
            }
        }
        if constexpr (ALIGN_EPI) { if (wr == 0) PG8_BAR; }
        if constexpr (!Epi::AFTER_DRAIN) { E(acc, cur, wr, wc, fr, fq); S.done(cur); }
        if (!has_next) break;
#pragma unroll
        for (int a = 0; a < 2; ++a)
#pragma unroll
            for (int b = 0; b < 2; ++b)
#pragma unroll
                for (int m = 0; m < 4; ++m)
#pragma unroll
                    for (int n = 0; n < 2; ++n) acc[a][b][m][n] = (f32x4){0.f, 0.f, 0.f, 0.f};
        cur = nxt; cA = nA; cB = nB; ++ui;
        if constexpr (ALIGN_EPI) { if (wr == 1) PG8_BAR; }
    }
    PG8_WAIT_V(0);
    if constexpr (!ALIGN_EPI) { if (wr == 0) PG8_BAR; }
    PG8_BAR;
    if constexpr (Epi::AFTER_DRAIN) { E.fused(acc, cur, wr, wc, fr, fq, lds, wid, lane); S.done(cur); }
#undef PG8_SA
#undef PG8_SB
#undef PG8_STAGE
#undef PG8_LDA
#undef PG8_LDB
#undef PG8_MMA
#undef PG8_WAIT_V
#undef PG8_WAIT_L
#undef PG8_BAR
#undef PG8_SCHED
}
}

constexpr int NB = 4, SEQ = 4096, DM = 1024, DEPTH = 4;
constexpr int M = NB * SEQ;
constexpr int ZP = 3328;
constexpr int NIN = 3144;
constexpr int DFF = 2816, PLE = 256;
constexpr float RMS_EPS = 1e-6f;
constexpr float LOG2E = 1.4426950408889634f;
constexpr float C2 = 0.125f * LOG2E;
constexpr int ZC_AIN = 0, ZC_AC = 256, ZC_AB = 512, ZC_PV = 768, ZC_Q = 1024  , ZC_K = 1536, ZC_V = 2048, ZC_IQ = 2560, ZC_IK = 3072, ZC_IW = 3136;

constexpr size_t MiB = 1u << 20;
constexpr size_t WS_CTL = 0, CTL_ZERO_BYTES = 64 * 1024;
constexpr size_t WS_RSSPX = 1 * MiB;
constexpr size_t WS_RSS1 = 2 * MiB;
constexpr size_t WS_RSSPT = 3 * MiB;
constexpr size_t WS_KM = 4 * MiB;
constexpr size_t WS_W = 8 * MiB;
constexpr size_t LW_WIN = 0, LW_WOUT = LW_WIN + (size_t)ZP * DM * 2, LW_WGU = LW_WOUT + (size_t)DM * DM * 2, LW_WD = LW_WGU + (size_t)2 * DFF * DM * 2,
                 LW_WG = LW_WD + (size_t)DM * DFF * 2, LW_WP = LW_WG + (size_t)DM * DM * 2, LW_BYTES = LW_WP + (size_t)DM * PLE * 2;
static_assert(LW_BYTES == 27 * MiB + MiB / 2, "per-layer weight block");
constexpr size_t WS_PB = WS_W + DEPTH * LW_BYTES;
constexpr size_t WS_XB = WS_PB + (size_t)DEPTH * M * PLE * 2;
constexpr size_t WS_RZ = WS_XB + (size_t)M * DM * 2;
constexpr size_t WS_RM = WS_RZ + (size_t)M * ZP * 2;
constexpr size_t WS_RV = WS_RM + (size_t)M * DM * 2;
constexpr size_t WS_VT = WS_RV, WS_DMASK = WS_RV + 16 * MiB;
constexpr size_t WS_END = WS_RV + 32 * MiB;
static_assert(WS_END == 350 * MiB, "workspace map");

constexpr int RING_BYTES = 131072;
constexpr int IDX_MROW_OFF = 131072;
constexpr int MISC_OFF = 143360;
constexpr int LDS_BYTES = 147456;
constexpr int NWAVES = 8, NTHREADS = 512;

#define LAS __attribute__((address_space(3)))
typedef unsigned short bf16;
typedef unsigned v4u __attribute__((ext_vector_type(4)));
typedef unsigned v2u __attribute__((ext_vector_type(2)));
typedef float f32x4 __attribute__((ext_vector_type(4)));
typedef float f32x16 __attribute__((ext_vector_type(16)));
typedef short bf16x8 __attribute__((ext_vector_type(8)));
typedef short s16x4 __attribute__((ext_vector_type(4)));
typedef unsigned long long u64;
#define LDS_WAIT() asm volatile("s_waitcnt lgkmcnt(0)" ::: "memory")
#define VM_WAIT() asm volatile("s_waitcnt vmcnt(0)" ::: "memory")
__device__ __forceinline__ unsigned f2bf(float f) { unsigned u = __builtin_bit_cast(unsigned, f); return (u + 0x7fffu + ((u >> 16) & 1u)) >> 16; }
__device__ __forceinline__ unsigned pk2(float lo, float hi) { return f2bf(lo) | (f2bf(hi) << 16); }
__device__ __forceinline__ float bflo(unsigned w) { return __builtin_bit_cast(float, w << 16); }
__device__ __forceinline__ float bfhi(unsigned w) { return __builtin_bit_cast(float, w & 0xffff0000u); }
__device__ __forceinline__ float bf1(bf16 v) { return __builtin_bit_cast(float, (unsigned)v << 16); }
__device__ __forceinline__ float wave_sum(float v) {
#pragma unroll
    for (int o = 1; o < 64; o <<= 1) v += __shfl_xor(v, o);
    return v;
}
__device__ __forceinline__ unsigned wave_sum_u(unsigned v) {
#pragma unroll
    for (int o = 1; o < 64; o <<= 1) v += (unsigned)__shfl_xor((int)v, o);
    return v;
}
__device__ __forceinline__ float sigmoidf_(float v) { return __builtin_amdgcn_rcpf(1.0f + __builtin_amdgcn_exp2f(-v * LOG2E)); }
#define XB_TMO      128
#define XB_XCNT(j)  (256  + 64 * (j))
#define XB_XSUB(j)  (1280 + 64 * (j))
#define XB_XGEN(j)  (2304 + 64 * (j))
#define XB_TOP      3328
#define XB_TOPGEN   3392
#define XCD_BAR_WORDS 3456
#define XB_SPIN_CAP (1u << 18)

__device__ __forceinline__ unsigned xb_ld(unsigned* p)              { return __hip_atomic_load(p, __ATOMIC_RELAXED, __HIP_MEMORY_SCOPE_AGENT); }
__device__ __forceinline__ unsigned xb_add(unsigned* p, unsigned v) { return __hip_atomic_fetch_add(p, v, __ATOMIC_RELAXED, __HIP_MEMORY_SCOPE_AGENT); }
__device__ __forceinline__ unsigned xb_xcc_id() { return (unsigned)__builtin_amdgcn_s_getreg((3 << 11) | 20) & 0xFu; }
#define XB_SPIN(cond, bar) do { unsigned _sp = 0; while (cond) { __builtin_amdgcn_s_sleep(1); \
    if ((++_sp & 255u) == 0u) { if (xb_ld(&(bar)[XB_TMO])) break; if (_sp > XB_SPIN_CAP) { atomicAdd(&(bar)[XB_TMO], 1u); break; } } } } while (0)

struct XcdBarrier {
    unsigned* bar; unsigned x;
    volatile LAS unsigned* st;
};

__device__ __forceinline__ XcdBarrier xcd_barrier_post(unsigned* bar, volatile LAS unsigned* st) {
    XcdBarrier b; b.bar = bar; b.x = xb_xcc_id(); b.st = st;
    if (threadIdx.x == 0) (void)xb_add(&bar[XB_XCNT(b.x)], 1u);
    return b;
}
__device__ __forceinline__ void xcd_barrier_complete(unsigned* bar, unsigned x, unsigned& nloc, unsigned& nx) {
    const unsigned G = gridDim.x * gridDim.y * gridDim.z;
    unsigned sum, cnt, mine, sp = 0u;
    for (;;) {
        sum = 0u; cnt = 0u; mine = 0u;
#pragma unroll
        for (unsigned j = 0; j < 16; ++j) { const unsigned c = xb_ld(&bar[XB_XCNT(j)]); sum += c; cnt += (c > 0u) ? 1u : 0u; mine = (j == x) ? c : mine; }
        if (sum == G) break;
        __builtin_amdgcn_s_sleep(1);
        if ((++sp & 255u) == 0u) { if (xb_ld(&bar[XB_TMO])) break; if (sp > XB_SPIN_CAP) { atomicAdd(&bar[XB_TMO], 1u); break; } }
    }
    nloc = mine > 0u ? mine : 1u; nx = cnt > 0u ? cnt : 1u;
}

__device__ __forceinline__ void xcd_barrier(const XcdBarrier& b) {
    asm volatile("s_waitcnt vmcnt(0)" ::: "memory");
    __syncthreads();
    if (threadIdx.x == 0) {
        unsigned* bar = b.bar;
        __builtin_amdgcn_s_waitcnt(0);
        unsigned nloc = b.st[0], nx = b.st[1];
        if (nloc == 0u) { xcd_barrier_complete(bar, b.x, nloc, nx); b.st[0] = nloc; b.st[1] = nx; }
        const unsigned old = xb_add(&bar[XB_XSUB(b.x)], 1u);
        const unsigned gen = old / nloc;
        if (old + 1u == (gen + 1u) * nloc) {
            __builtin_amdgcn_fence(__ATOMIC_RELEASE, "agent");
            asm volatile("s_waitcnt vmcnt(0)" ::: "memory");
            const unsigned og = xb_add(&bar[XB_TOP], 1u);
            const unsigned tg = og / nx;
            if (og + 1u == (tg + 1u) * nx) xb_add(&bar[XB_TOPGEN], 1u);
            else XB_SPIN(xb_ld(&bar[XB_TOPGEN]) == tg, bar);
            __builtin_amdgcn_fence(__ATOMIC_ACQUIRE, "agent");
            xb_add(&bar[XB_XGEN(b.x)], 1u);
            asm volatile("s_waitcnt vmcnt(0)" ::: "memory");
        } else {
            XB_SPIN(xb_ld(&bar[XB_XGEN(b.x)]) == gen, bar);
            __builtin_amdgcn_fence(__ATOMIC_ACQUIRE, "agent");
            asm volatile("s_waitcnt vmcnt(0)" ::: "memory");
        }
    }
    __syncthreads();
}

struct Args { const float* in[17]; float* out; unsigned char* ws; int ph_lo, ph_hi; };
struct Frame {
    LAS unsigned char* lds;
    int tid, lane, wave, vcu, G, bx;
    const float* const* in;
    float* X; unsigned char* ws;
};
#define IN_X 0
#define IN_P 1
#define IN_RELB 2
#define IN_GMIXPRE 3
#define IN_WIN 4
#define IN_CONVW 5
#define IN_POOLW 6
#define IN_POOLS 7
#define IN_WOUT 8
#define IN_GMIXPOST 9
#define IN_GFFNPRE 10
#define IN_WGU 11
#define IN_WDOWN 12
#define IN_GFFNPOST 13
#define IN_GPLE 14
#define IN_WPLEG 15
#define IN_WPLEP 16

typedef pg8::f32x4 (&AccRef)[2][2][4][2];
typedef const pg8::f32x4 (&AccCRef)[2][2][4][2];
__device__ __forceinline__ float dot4(f32x4 a) { return (a[0] * a[0] + a[1] * a[1]) + (a[2] * a[2] + a[3] * a[3]); }

struct EpiZ {
    static constexpr bool PERM = true, AFTER_DRAIN = false;
    bf16* Z; const float* rssp;
    __device__ __forceinline__ void operator()(AccCRef acc, const pg8::Unit& u, int wr, int wc, int fr, int fq) const {
        const int row0 = u.pm * 256 + wr * 64 + fr, col0 = u.pn * 256 + wc * 32 + 8 * fq;
#pragma unroll
        for (int ai = 0; ai < 2; ++ai)
#pragma unroll
            for (int m = 0; m < 4; ++m) {
                const int row = row0 + ai * 128 + m * 16;
                const f32x4* rp = (const f32x4*)(rssp + (size_t)row * 16);
                const f32x4 a = rp[0], b = rp[1], c = rp[2], d = rp[3];
                const float ss = ((a[0] + a[1]) + (a[2] + a[3])) + ((b[0] + b[1]) + (b[2] + b[3])) + ((c[0] + c[1]) + (c[2] + c[3])) + ((d[0] + d[1]) + (d[2] + d[3]));
                const float rs = rsqrtf(ss * (1.0f / DM) + RMS_EPS);
                bf16* rowp = Z + (size_t)row * ZP + col0;
#pragma unroll
                for (int bj = 0; bj < 2; ++bj) {
                    const f32x4 v0 = acc[ai][bj][m][0] * rs, v1 = acc[ai][bj][m][1] * rs;
                    v4u w; w.x = pk2(v0[0], v0[1]); w.y = pk2(v0[2], v0[3]); w.z = pk2(v1[0], v1[1]); w.w = pk2(v1[2], v1[3]);
                    *(v4u*)(rowp + bj * 128) = w;
                }
            }
    }
};
struct EpiT {
    static constexpr bool PERM = true, AFTER_DRAIN = false;
    bf16* T; float* rssp;
    __device__ __forceinline__ void operator()(AccCRef acc, const pg8::Unit& u, int wr, int wc, int fr, int fq) const {
        const int row0 = u.pm * 256 + wr * 64 + fr, col0 = u.pn * 256 + wc * 32 + 8 * fq;
#pragma unroll
        for (int ai = 0; ai < 2; ++ai)
#pragma unroll
            for (int m = 0; m < 4; ++m) {
                const int row = row0 + ai * 128 + m * 16;
                bf16* rowp = T + (size_t)row * DM + col0;
                float ss = 0.f;
#pragma unroll
                for (int bj = 0; bj < 2; ++bj) {
                    const f32x4 v0 = acc[ai][bj][m][0], v1 = acc[ai][bj][m][1];
                    ss += dot4(v0) + dot4(v1);
                    v4u w; w.x = pk2(v0[0], v0[1]); w.y = pk2(v0[2], v0[3]); w.z = pk2(v1[0], v1[1]); w.w = pk2(v1[2], v1[3]);
                    *(v4u*)(rowp + bj * 128) = w;
                }
                ss += __shfl_xor(ss, 16); ss += __shfl_xor(ss, 32);
                if (fq == 0) rssp[(size_t)row * 16 + u.pn * 4 + wc] = ss;
            }
    }
};
struct EpiB {
    static constexpr bool PERM = true, AFTER_DRAIN = false;
    bf16* T;
    __device__ __forceinline__ void operator()(AccCRef acc, const pg8::Unit& u, int wr, int wc, int fr, int fq) const {
        const int row0 = u.pm * 256 + wr * 64 + fr, col0 = u.pn * 256 + wc * 32 + 8 * fq;
#pragma unroll
        for (int ai = 0; ai < 2; ++ai)
#pragma unroll
            for (int m = 0; m < 4; ++m) {
                bf16* rowp = T + (size_t)(row0 + ai * 128 + m * 16) * DM + col0;
#pragma unroll
                for (int bj = 0; bj < 2; ++bj) {
                    const f32x4 v0 = acc[ai][bj][m][0], v1 = acc[ai][bj][m][1];
                    v4u w; w.x = pk2(v0[0], v0[1]); w.y = pk2(v0[2], v0[3]); w.z = pk2(v1[0], v1[1]); w.w = pk2(v1[2], v1[3]);
                    *(v4u*)(rowp + bj * 128) = w;
                }
            }
    }
};
struct EpiSwiGLU {
    static constexpr bool PERM = true, AFTER_DRAIN = false;
    bf16* H; const float* rss1;
    __device__ __forceinline__ void operator()(AccCRef acc, const pg8::Unit& u, int wr, int wc, int fr, int fq) const {
        const int row0 = u.pm * 256 + wr * 64 + fr, col0 = u.pn * 128 + wc * 32 + 8 * fq;
#pragma unroll
        for (int ai = 0; ai < 2; ++ai)
#pragma unroll
            for (int m = 0; m < 4; ++m) {
                const int row = row0 + ai * 128 + m * 16;
                const float rs = rsqrtf(rss1[row] * (1.0f / DM) + RMS_EPS);
                float h[8];
#pragma unroll
                for (int n = 0; n < 2; ++n)
#pragma unroll
                    for (int j = 0; j < 4; ++j) { const float g = acc[ai][0][m][n][j] * rs, up = acc[ai][1][m][n][j] * rs; h[n * 4 + j] = g * up * sigmoidf_(g); }
                v4u w; w.x = pk2(h[0], h[1]); w.y = pk2(h[2], h[3]); w.z = pk2(h[4], h[5]); w.w = pk2(h[6], h[7]);
                *(v4u*)(H + (size_t)row * DFF + col0) = w;
            }
    }
};
struct EpiPLE {
    static constexpr bool PERM = false, AFTER_DRAIN = false;
    float* X; bf16* XB; const bf16* T2; const float* rss1; float* rssp;
    __device__ __forceinline__ void operator()(AccCRef acc, const pg8::Unit& u, int wr, int wc, int fr, int fq) const {
        const int row0 = u.pm * 256 + wr * 64 + fr, col0 = u.pn * 256 + wc * 32 + 4 * fq;
#pragma unroll
        for (int ai = 0; ai < 2; ++ai)
#pragma unroll
            for (int m = 0; m < 4; ++m) {
                const int row = row0 + ai * 128 + m * 16;
                const float rs = rsqrtf(rss1[row] * (1.0f / DM) + RMS_EPS);
                float ss = 0.f;
#pragma unroll
                for (int bj = 0; bj < 2; ++bj)
#pragma unroll
                    for (int n = 0; n < 2; ++n) {
                        const size_t off = (size_t)row * DM + col0 + bj * 128 + n * 16;
                        const f32x4 xo = *(const f32x4*)(X + off); const v2u t2 = *(const v2u*)(T2 + off);
                        const f32x4 a = acc[ai][bj][m][n] * rs;
                        f32x4 xn;
                        xn[0] = xo[0] + sigmoidf_(a[0]) * bflo(t2.x); xn[1] = xo[1] + sigmoidf_(a[1]) * bfhi(t2.x);
                        xn[2] = xo[2] + sigmoidf_(a[2]) * bflo(t2.y); xn[3] = xo[3] + sigmoidf_(a[3]) * bfhi(t2.y);
                        ss += dot4(xn);
                        *(f32x4*)(X + off) = xn;
                        v2u w; w.x = pk2(xn[0], xn[1]); w.y = pk2(xn[2], xn[3]); *(v2u*)(XB + off) = w;
                    }
                ss += __shfl_xor(ss, 16); ss += __shfl_xor(ss, 32);
                if (fq == 0) rssp[(size_t)row * 16 + u.pn * 4 + wc] = ss;
            }
    }
};

__device__ __forceinline__ int win_src(int n) {
    if (n < 1280) return n;
    if (n < 1536) return 2376 + (n - 1280);
    if (n < 1792) return 1280 + (n - 1536);
    if (n < 2048) return 2632 + (n - 1792);
    if (n < 2304) return 1536 + (n - 2048);
    if (n < 2560) return 2888 + (n - 2304);
    if (n < 3072) return 1792 + (n - 2560);
    if (n < 3136) return 2304 + (n - 3072);
    if (n < 3144) return 2368 + (n - 3136);
    return -1;
}
template <int MAP>
__device__ __forceinline__ void tr_item(const float* W, int K, int Nsrc, int Ndst, const float* g, bf16* WT, LAS float* scr, int item, int lane) {
    const int nblk = Ndst / 32, kb = item / nblk, nb = item % nblk, k0 = 64 * kb, n0 = 32 * nb;
    const int nd = n0 + (lane & 31);
    int ns; float cs = 1.0f;
    if (MAP == 0) ns = nd;
    else if (MAP == 1) { ns = win_src(nd); if (nd >= ZC_Q && nd < ZC_K) cs = C2; }
    else { const int pn = nd >> 8, r = nd & 255; ns = (r < 128) ? (pn * 128 + r) : (DFF + pn * 128 + (r - 128)); }
#pragma unroll 8
    for (int i = 0; i < 32; ++i) {
        const int kk = 2 * i + (lane >> 5);
        float v = 0.f;
        if (ns >= 0) v = W[(size_t)(k0 + kk) * Nsrc + ns] * cs;
        if (g) v *= g[k0 + kk];
        scr[kk * 33 + (lane & 31)] = v;
    }
    LDS_WAIT(); asm volatile("" ::: "memory");
    const int c = lane & 7;
#pragma unroll
    for (int j = 0; j < 4; ++j) {
        const int n = (lane >> 3) + 8 * j; const LAS float* s = scr + (8 * c) * 33 + n;
        v4u o; o.x = pk2(s[0 * 33], s[1 * 33]); o.y = pk2(s[2 * 33], s[3 * 33]); o.z = pk2(s[4 * 33], s[5 * 33]); o.w = pk2(s[6 * 33], s[7 * 33]);
        *(v4u*)(WT + (size_t)(n0 + n) * K + k0 + 8 * c) = o;
    }
    LDS_WAIT(); asm volatile("" ::: "memory");
}
__device__ __forceinline__ void phase_prologue(const Frame& F) {
    LAS float* scr = (LAS float*)(F.lds + F.wave * 16384);
    const int gw = F.vcu * NWAVES + F.wave, NGW = F.G * NWAVES, lane = F.lane;
    constexpr int I_WIN = (DM / 64) * (ZP / 32), I_WOUT = (DM / 64) * (DM / 32), I_WGU = (DM / 64) * (2 * DFF / 32), I_WD = (DFF / 64) * (DM / 32), I_WG = I_WOUT, I_WP = (PLE / 64) * (DM / 32);
    constexpr int I_LAYER = I_WIN + I_WOUT + I_WGU + I_WD + I_WG + I_WP;
    for (int it = gw; it < DEPTH * I_LAYER; it += NGW) {
        const int L = it / I_LAYER; int r = it % I_LAYER;
        unsigned char* wl = F.ws + WS_W + (size_t)L * LW_BYTES;
        if (r < I_WIN) { tr_item<1>(F.in[IN_WIN] + (size_t)L * DM * NIN, DM, NIN, ZP, F.in[IN_GMIXPRE] + L * DM, (bf16*)(wl + LW_WIN), scr, r, lane); continue; } r -= I_WIN;
        if (r < I_WOUT) { tr_item<0>(F.in[IN_WOUT] + (size_t)L * DM * DM, DM, DM, DM, nullptr, (bf16*)(wl + LW_WOUT), scr, r, lane); continue; } r -= I_WOUT;
        if (r < I_WGU) { tr_item<2>(F.in[IN_WGU] + (size_t)L * DM * 2 * DFF, DM, 2 * DFF, 2 * DFF, F.in[IN_GFFNPRE] + L * DM, (bf16*)(wl + LW_WGU), scr, r, lane); continue; } r -= I_WGU;
        if (r < I_WD) { tr_item<0>(F.in[IN_WDOWN] + (size_t)L * DFF * DM, DFF, DM, DM, nullptr, (bf16*)(wl + LW_WD), scr, r, lane); continue; } r -= I_WD;
        if (r < I_WG) { tr_item<0>(F.in[IN_WPLEG] + (size_t)L * DM * DM, DM, DM, DM, F.in[IN_GPLE] + L * DM, (bf16*)(wl + LW_WG), scr, r, lane); continue; } r -= I_WG;
        tr_item<0>(F.in[IN_WPLEP] + (size_t)L * PLE * DM, PLE, DM, DM, nullptr, (bf16*)(wl + LW_WP), scr, r, lane);
    }
    {
        const f32x4* src = (const f32x4*)F.in[IN_P]; v2u* dst = (v2u*)(F.ws + WS_PB);
        const size_t n4 = (size_t)DEPTH * M * PLE / 4;
        for (size_t i = (size_t)F.vcu * NTHREADS + F.tid; i < n4; i += (size_t)F.G * NTHREADS) { const f32x4 v = src[i]; v2u w; w.x = pk2(v[0], v[1]); w.y = pk2(v[2], v[3]); dst[i] = w; }
    }
    {
        const float* x = F.in[IN_X]; bf16* XB = (bf16*)(F.ws + WS_XB); float* rssp = (float*)(F.ws + WS_RSSPX);
        for (int row = gw; row < M; row += NGW) {
            const f32x4* xr = (const f32x4*)(x + (size_t)row * DM) + lane; f32x4* xo = (f32x4*)(F.X + (size_t)row * DM) + lane; v2u* xb = (v2u*)(XB + (size_t)row * DM) + lane;
            float ss = 0.f;
#pragma unroll
            for (int j = 0; j < 4; ++j) { const f32x4 v = xr[64 * j]; ss += dot4(v); xo[64 * j] = v; v2u w; w.x = pk2(v[0], v[1]); w.y = pk2(v[2], v[3]); xb[64 * j] = w; }
            ss = wave_sum(ss);
            if (lane < 16) rssp[(size_t)row * 16 + lane] = (lane == 0) ? ss : 0.f;
        }
    }
}

__device__ __forceinline__ void phase_resid(const Frame& F, const bf16* T, const float* rsspt, const float* g) {
    const int gw = F.vcu * NWAVES + F.wave, NGW = F.G * NWAVES, lane = F.lane;
    bf16* XB = (bf16*)(F.ws + WS_XB); float* rss1 = (float*)(F.ws + WS_RSS1);
    f32x4 gv[4];
#pragma unroll
    for (int j = 0; j < 4; ++j) gv[j] = ((const f32x4*)g)[lane + 64 * j];
    for (int row = gw; row < M; row += NGW) {
        const f32x4* rp = (const f32x4*)(rsspt + (size_t)row * 16);
        const f32x4 a = rp[0], b = rp[1], c = rp[2], d = rp[3];
        const float st = ((a[0] + a[1]) + (a[2] + a[3])) + ((b[0] + b[1]) + (b[2] + b[3])) + ((c[0] + c[1]) + (c[2] + c[3])) + ((d[0] + d[1]) + (d[2] + d[3]));
        const float rs = rsqrtf(st * (1.0f / DM) + RMS_EPS);
        f32x4* xr = (f32x4*)(F.X + (size_t)row * DM) + lane; const v2u* tr = (const v2u*)(T + (size_t)row * DM) + lane; v2u* xb = (v2u*)(XB + (size_t)row * DM) + lane;
        float ss = 0.f;
#pragma unroll
        for (int j = 0; j < 4; ++j) {
            f32x4 v = xr[64 * j]; const v2u t = tr[64 * j];
            v[0] += gv[j][0] * bflo(t.x) * rs; v[1] += gv[j][1] * bfhi(t.x) * rs; v[2] += gv[j][2] * bflo(t.y) * rs; v[3] += gv[j][3] * bfhi(t.y) * rs;
            ss += dot4(v); xr[64 * j] = v; v2u w; w.x = pk2(v[0], v[1]); w.y = pk2(v[2], v[3]); xb[64 * j] = w;
        }
        ss = wave_sum(ss);
        if (lane == 0) rss1[row] = ss;
    }
}

__device__ __forceinline__ void phase_prep(const Frame& F, int L) {
    const bf16* Z = (const bf16*)(F.ws + WS_RZ); bf16* MIX = (bf16*)(F.ws + WS_RM);
    const int tid = F.tid, lane = F.lane, wave = F.wave;
    {
        const float* cw = F.in[IN_CONVW] + (size_t)L * 3 * 256;
        for (size_t i = (size_t)F.vcu * NTHREADS + tid; i < (size_t)M * 32; i += (size_t)F.G * NTHREADS) {
            const int row = (int)(i >> 5), c0 = (int)(i & 31) * 8, t = row & (SEQ - 1);
            float accv[8];
#pragma unroll
            for (int e = 0; e < 8; ++e) accv[e] = 0.f;
#pragma unroll
            for (int j = 0; j < 3; ++j) {
                const int tt = t - 2 + j;
                if (tt >= 0) {
                    const bf16* zr = Z + (size_t)(row - 2 + j) * ZP;
                    const v4u ain = *(const v4u*)(zr + ZC_AIN + c0), ac = *(const v4u*)(zr + ZC_AC + c0);
                    const f32x4 w0 = *(const f32x4*)(cw + j * 256 + c0), w1 = *(const f32x4*)(cw + j * 256 + c0 + 4);
                    accv[0] += w0[0] * bflo(ain.x) * bflo(ac.x); accv[1] += w0[1] * bfhi(ain.x) * bfhi(ac.x);
                    accv[2] += w0[2] * bflo(ain.y) * bflo(ac.y); accv[3] += w0[3] * bfhi(ain.y) * bfhi(ac.y);
                    accv[4] += w1[0] * bflo(ain.z) * bflo(ac.z); accv[5] += w1[1] * bfhi(ain.z) * bfhi(ac.z);
                    accv[6] += w1[2] * bflo(ain.w) * bflo(ac.w); accv[7] += w1[3] * bfhi(ain.w) * bfhi(ac.w);
                }
            }
            const v4u ab = *(const v4u*)(Z + (size_t)row * ZP + ZC_AB + c0);
            v4u o; o.x = pk2(accv[0] * bflo(ab.x), accv[1] * bfhi(ab.x)); o.y = pk2(accv[2] * bflo(ab.y), accv[3] * bfhi(ab.y));
            o.z = pk2(accv[4] * bflo(ab.z), accv[5] * bfhi(ab.z)); o.w = pk2(accv[6] * bflo(ab.w), accv[7] * bfhi(ab.w));
            *(v4u*)(MIX + (size_t)row * DM + c0) = o;
        }
    }
    {
        LAS float* Vs = (LAS float*)F.lds; LAS float* Ds = (LAS float*)(F.lds + 49152);
        const float* pw = F.in[IN_POOLW] + (size_t)L * 4 * 64 * 64; const float* ps = F.in[IN_POOLS] + (size_t)L * 256;
        const int oc = tid & 255, og = oc >> 6, oo = oc & 63, th = tid >> 8;
        float wreg[64];
#pragma unroll
        for (int c = 0; c < 64; ++c) wreg[c] = pw[(og * 64 + c) * 64 + oo];
        const float psc = ps[oc];
        for (int tile = F.vcu; tile < M / 32; tile += F.G) {
            const int row0 = tile * 32, t0 = row0 & (SEQ - 1);
            __syncthreads();
            for (int i = tid; i < 48 * 32; i += NTHREADS) {
                const int r = i >> 5, c0 = (i & 31) * 8, tt = t0 - 16 + r;
                float v[8];
                if (tt >= 0) { const v4u z = *(const v4u*)(Z + (size_t)(row0 - 16 + r) * ZP + ZC_PV + c0);
                    v[0] = bflo(z.x); v[1] = bfhi(z.x); v[2] = bflo(z.y); v[3] = bfhi(z.y); v[4] = bflo(z.z); v[5] = bfhi(z.z); v[6] = bflo(z.w); v[7] = bfhi(z.w); }
                else {
#pragma unroll
                    for (int e = 0; e < 8; ++e) v[e] = 0.f; }
#pragma unroll
                for (int e = 0; e < 8; ++e) Vs[r * 256 + c0 + e] = v[e];
            }
            __syncthreads();
            {
                const int w = 2 << og;
                for (int tl = th * 16; tl < th * 16 + 16; ++tl) {
                    float s = 0.f;
                    for (int j = 0; j < w; ++j) s += Vs[(tl + 16 - j) * 256 + oc];
                    const int tg = t0 + tl; const int cnt = (tg + 1 < w) ? (tg + 1) : w;
                    Ds[tl * 256 + oc] = s / (float)cnt - Vs[(tl + 16) * 256 + oc];
                }
            }
            __syncthreads();
            for (int tl = th * 16; tl < th * 16 + 16; ++tl) {
                const LAS f32x4* dr = (const LAS f32x4*)(Ds + tl * 256 + og * 64);
                float a = 0.f;
#pragma unroll
                for (int c4 = 0; c4 < 16; ++c4) { const f32x4 d = dr[c4]; a += d[0] * wreg[4 * c4] + d[1] * wreg[4 * c4 + 1] + d[2] * wreg[4 * c4 + 2] + d[3] * wreg[4 * c4 + 3]; }
                MIX[(size_t)(row0 + tl) * DM + 256 + oc] = (bf16)f2bf(a * psc);
            }
        }
        __syncthreads();
    }
    {
        bf16* Vt = (bf16*)(F.ws + WS_VT);
        LAS bf16* tl = (LAS bf16*)(F.lds + wave * 16384);
        const int gw = F.vcu * NWAVES + wave, NGW = F.G * NWAVES;
        for (int it = gw; it < NB * 8 * (SEQ / 64); it += NGW) {
            const int st = it & 63, bh = it >> 6, b = bh >> 3, h = bh & 7;
            const bf16* src = Z + (size_t)(b * SEQ + st * 64 + lane) * ZP + ZC_V + h * 64;
#pragma unroll
            for (int c = 0; c < 8; ++c) { const v4u v = *(const v4u*)(src + c * 8);
                const unsigned ww[4] = {v.x, v.y, v.z, v.w};
#pragma unroll
                for (int e = 0; e < 4; ++e) { tl[(c * 8 + 2 * e) * 66 + lane] = (bf16)(ww[e] & 0xffffu); tl[(c * 8 + 2 * e + 1) * 66 + lane] = (bf16)(ww[e] >> 16); } }
            LDS_WAIT(); asm volatile("" ::: "memory");
            bf16* dst = Vt + ((size_t)bh * 64 + lane) * SEQ + st * 64;
#pragma unroll
            for (int c = 0; c < 8; ++c) { v4u o; const LAS unsigned* s = (const LAS unsigned*)(tl + lane * 66 + c * 8); o.x = s[0]; o.y = s[1]; o.z = s[2]; o.w = s[3]; *(v4u*)(dst + c * 8) = o; }
            LDS_WAIT(); asm volatile("" ::: "memory");
        }
    }
    {
        float* KM = (float*)(F.ws + WS_KM);
        LAS float* red = (LAS float*)(F.lds + 131072);
        for (int it = F.vcu; it < NB * 16; it += F.G) {
            const int col = tid & 255, half = tid >> 8;
            const bf16* src = Z + (size_t)(it * 256 + half * 128) * ZP + ZC_K + 256 + col;
            float s = 0.f;
            for (int r = 0; r < 128; ++r) s += bf1(src[(size_t)r * ZP]);
            __syncthreads();
            if (half == 1) red[col] = s;
            __syncthreads();
            if (half == 0) KM[(size_t)it * 256 + col] = (s + red[col]) * (1.0f / 256.0f);
        }
        __syncthreads();
    }
}

typedef unsigned short u16x2 __attribute__((ext_vector_type(2)));
__device__ __forceinline__ unsigned cnt_ge_word(unsigned w, u16x2 cm1) {
    const u16x2 x = __builtin_bit_cast(u16x2, w);
    u16x2 d = __builtin_elementwise_sub_sat(x, cm1);
    const u16x2 one = {1, 1};
    d = __builtin_elementwise_min(d, one);
    return __builtin_bit_cast(unsigned, d);
}
__device__ __forceinline__ unsigned count_ge(const LAS unsigned short* row, int nchunks, unsigned cand, int lane) {
    const unsigned short c1 = (unsigned short)(cand - 1u); const u16x2 cm1 = {c1, c1};
    unsigned acc = 0;
    for (int c = 0; c < nchunks; ++c) {
        const v4u v = *(const LAS v4u*)(row + c * 512 + lane * 8);
        acc += cnt_ge_word(v.x, cm1) + cnt_ge_word(v.y, cm1) + cnt_ge_word(v.z, cm1) + cnt_ge_word(v.w, cm1);
    }
    return wave_sum_u((acc & 0xffffu) + (acc >> 16));
}
__device__ __forceinline__ void idx_tile(const Frame& F, int b, int qt) {
    const bf16* Z = (const bf16*)(F.ws + WS_RZ); u64* DMK = (u64*)(F.ws + WS_DMASK);
    LAS unsigned short* keys = (LAS unsigned short*)F.lds; LAS unsigned char* mrow = (LAS unsigned char*)(F.lds + IDX_MROW_OFF);
    const int tid = F.tid, lane = F.lane, wave = F.wave, q0 = qt * 16;
    if (qt < 16) {
        for (int i = tid; i < 16 * 512; i += NTHREADS) { const int qi = i >> 9, bi = i & 511, q = q0 + qi, k0 = bi * 8;
            mrow[i] = (unsigned char)((k0 + 7 <= q) ? 0xFFu : ((k0 > q) ? 0u : ((1u << (q - k0 + 1)) - 1u))); }
    } else {
        const int nchunks = (q0 + 16 + 511) >> 9;
        const size_t rb = (size_t)b * SEQ;
        {
            const int fr = lane & 15, fq = lane >> 4;
            bf16x8 A[8][2];
            const bf16* qrow = Z + (rb + q0 + fr) * ZP + ZC_IQ + fq * 8;
#pragma unroll
            for (int h = 0; h < 8; ++h)
#pragma unroll
                for (int ks = 0; ks < 2; ++ks) A[h][ks] = *(const bf16x8*)(qrow + h * 64 + ks * 32);
            float iw[4][8];
#pragma unroll
            for (int i = 0; i < 4; ++i) { const v4u w = *(const v4u*)(Z + (rb + q0 + fq * 4 + i) * ZP + ZC_IW);
                iw[i][0] = bflo(w.x); iw[i][1] = bfhi(w.x); iw[i][2] = bflo(w.y); iw[i][3] = bfhi(w.y); iw[i][4] = bflo(w.z); iw[i][5] = bfhi(w.z); iw[i][6] = bflo(w.w); iw[i][7] = bfhi(w.w); }
            for (int kt = wave; kt < nchunks * 32; kt += NWAVES) {
                const int key = kt * 16 + fr;
                const bf16* krow = Z + (rb + key) * ZP + ZC_IK + fq * 8;
                const bf16x8 B0 = *(const bf16x8*)(krow), B1 = *(const bf16x8*)(krow + 32);
                float sc[4] = {0.f, 0.f, 0.f, 0.f};
#pragma unroll
                for (int h = 0; h < 8; ++h) {
                    pg8::f32x4 acc = {0.f, 0.f, 0.f, 0.f};
                    acc = __builtin_amdgcn_mfma_f32_16x16x32_bf16(A[h][0], B0, acc, 0, 0, 0);
                    acc = __builtin_amdgcn_mfma_f32_16x16x32_bf16(A[h][1], B1, acc, 0, 0, 0);
#pragma unroll
                    for (int i = 0; i < 4; ++i) sc[i] += iw[i][h] * fmaxf(acc[i], 0.f);
                }
#pragma unroll
                for (int i = 0; i < 4; ++i) {
                    const int qi = fq * 4 + i;
                    const _Float16 hv = (_Float16)sc[i];
                    const unsigned bits = (unsigned)__builtin_bit_cast(unsigned short, hv);
                    unsigned mono = (bits & 0x8000u) ? (~bits & 0xffffu) : (bits | 0x8000u);
                    if (key > q0 + qi) mono = 0u;
                    keys[qi * 4096 + key] = (unsigned short)mono;
                }
            }
        }
        __syncthreads();
        for (int qq = 0; qq < 2; ++qq) {
            const int qi = wave + 8 * qq;
            const LAS unsigned short* row = keys + qi * 4096;
            unsigned T = 0;
            for (int bit = 15; bit >= 0; --bit) { const unsigned cand = T | (1u << bit); if (count_ge(row, nchunks, cand, lane) >= 256u) T = cand; }
            const unsigned cnt_gt = (T == 0xffffu) ? 0u : count_ge(row, nchunks, T + 1u, lane);
            const unsigned need_eq = 256u - cnt_gt;
            unsigned base = 0;
            LAS unsigned char* mr = mrow + qi * 512;
            for (int c = 0; c < nchunks; ++c) {
                const v4u v = *(const LAS v4u*)(row + c * 512 + lane * 8);
                const unsigned ww[4] = {v.x, v.y, v.z, v.w};
                unsigned gtb = 0, eqb = 0;
#pragma unroll
                for (int e = 0; e < 4; ++e) { const unsigned lo = ww[e] & 0xffffu, hi = ww[e] >> 16;
                    gtb |= (lo > T ? 1u : 0u) << (2 * e); gtb |= (hi > T ? 1u : 0u) << (2 * e + 1);
                    eqb |= (lo == T ? 1u : 0u) << (2 * e); eqb |= (hi == T ? 1u : 0u) << (2 * e + 1); }
                const unsigned e = (unsigned)__builtin_popcount(eqb);
                unsigned incl = e;
#pragma unroll
                for (int o = 1; o < 64; o <<= 1) { const unsigned t = (unsigned)__shfl_up((int)incl, o); if (lane >= o) incl += t; }
                unsigned rank = base + incl - e, sel = gtb;
#pragma unroll
                for (int j = 0; j < 8; ++j) { if ((eqb >> j) & 1u) { if (rank < need_eq) sel |= 1u << j; ++rank; } }
                mr[c * 64 + lane] = (unsigned char)sel;
                base += (unsigned)__shfl((int)incl, 63);
            }
            for (int i = nchunks * 64 + lane; i < 512; i += 64) mr[i] = 0;
        }
    }
    __syncthreads();
    for (int i = tid; i < 1024; i += NTHREADS) { const int t64 = i >> 4, qi = i & 15;
        const LAS unsigned* s = (const LAS unsigned*)(mrow + qi * 512 + t64 * 8);
        DMK[((size_t)(b * 64 + t64)) * SEQ + q0 + qi] = (u64)s[0] | ((u64)s[1] << 32); }
    __syncthreads();
}
__device__ __forceinline__ void phase_index(const Frame& F) {
    for (int pi = F.vcu; pi < 512; pi += F.G) { const int b = pi >> 7, s = pi & 127; idx_tile(F, b, s); idx_tile(F, b, 255 - s); }
}

__device__ __forceinline__ int crow(int r, int hi) { return (r & 3) + 8 * (r >> 2) + 4 * hi; }
__device__ __forceinline__ unsigned cvtpk(float lo, float hi) { typedef float f2 __attribute__((ext_vector_type(2))); typedef __bf16 b2 __attribute__((ext_vector_type(2)));
    f2 v = {lo, hi}; b2 b = __builtin_convertvector(v, b2); return __builtin_bit_cast(unsigned, b); }
#define MFMA32(a, b, c) __builtin_amdgcn_mfma_f32_32x32x16_bf16((a), (b), (c), 0, 0, 0)
__device__ __forceinline__ void attn_unit(const Frame& F, int b, int h8, int qb) {
    const bf16* Z = (const bf16*)(F.ws + WS_RZ); const bf16* Vt = (const bf16*)(F.ws + WS_VT); const u64* DMK = (const u64*)(F.ws + WS_DMASK);
    const float* KM = (const float*)(F.ws + WS_KM); bf16* MIX = (bf16*)(F.ws + WS_RM);
    LAS unsigned char* lds = F.lds; const LAS float* biasT = (const LAS float*)(F.lds + 32768) + h8 * 128;
    const int tid = F.tid, lane = F.lane, w = F.wave, r32 = lane & 31, hi = lane >> 5;
    const bool moba = h8 >= 4;
    const int q0 = qb * 256, qw0 = q0 + w * 32, q = qw0 + r32;
    const size_t rb = (size_t)b * SEQ;
    bf16x8 qf[4];
    { const bf16* Qp = Z + (rb + q) * ZP + ZC_Q + h8 * 64 + 8 * hi;
#pragma unroll
      for (int d0 = 0; d0 < 4; ++d0) qf[d0] = *(const bf16x8*)(Qp + 16 * d0); }
    unsigned selmask = 0;
    if (moba && qb > 0) {
        float qv[64];
        { const bf16* Qr = Z + (rb + q) * ZP + ZC_Q + h8 * 64;
#pragma unroll
          for (int c = 0; c < 8; ++c) { const v4u v = *(const v4u*)(Qr + c * 8);
              qv[c * 8 + 0] = bflo(v.x); qv[c * 8 + 1] = bfhi(v.x); qv[c * 8 + 2] = bflo(v.y); qv[c * 8 + 3] = bfhi(v.y); qv[c * 8 + 4] = bflo(v.z); qv[c * 8 + 5] = bfhi(v.z); qv[c * 8 + 6] = bflo(v.w); qv[c * 8 + 7] = bfhi(v.w); } }
        float g0 = -INFINITY, g1 = -INFINITY, g2 = -INFINITY; int i0 = -1, i1 = -1, i2 = -1;
        for (int n = 0; n < qb; ++n) {
            const float* km = KM + ((size_t)(b * 16 + n) * 4 + (h8 - 4)) * 64;
            float g = 0.f;
#pragma unroll
            for (int d = 0; d < 64; ++d) g += qv[d] * km[d];
            if (g > g0) { g2 = g1; i2 = i1; g1 = g0; i1 = i0; g0 = g; i0 = n; }
            else if (g > g1) { g2 = g1; i2 = i1; g1 = g; i1 = n; }
            else if (g > g2) { g2 = g; i2 = n; }
        }
        if (i0 >= 0) selmask |= 1u << i0; if (i1 >= 0) selmask |= 1u << i1; if (i2 >= 0) selmask |= 1u << i2;
    }
    f32x16 o0, o1;
#pragma unroll
    for (int r = 0; r < 16; ++r) { o0[r] = 0.f; o1[r] = 0.f; }
    float mrun = 0.f, lrun = 0.f;
    const float biasfar = biasT[127];
    const int ntiles = 4 * (qb + 1);
    const int lrow = tid >> 3, lch = tid & 7;
    const bf16* Kg = Z + (rb + lrow) * ZP + ZC_K + h8 * 64 + lch * 8;
    const bf16* Vg = Vt + ((size_t)(b * 8 + h8) * 64 + lrow) * SEQ + lch * 8;
    const int st_off = lrow * 128 + ((lch ^ (lrow & 7)) << 4);
    v4u kreg = *(const v4u*)Kg, vreg = *(const v4u*)Vg;
    for (int t = 0; t < ntiles; ++t) {
        const int buf = (t & 1) * 8192;
        *(LAS v4u*)(lds + buf + st_off) = kreg; *(LAS v4u*)(lds + 16384 + buf + st_off) = vreg;
        __syncthreads();
        if (t + 1 < ntiles) { kreg = *(const v4u*)(Kg + (size_t)(t + 1) * 64 * ZP); vreg = *(const v4u*)(Vg + (t + 1) * 64); }
        if (64 * t > qw0 + 31) continue;
        u64 word;
        if (!moba) word = DMK[((size_t)(b * 64 + t)) * SEQ + q];
        else { const int blk = t >> 2;
            if (blk == qb) { const int rel = q - 64 * t; word = (rel >= 63) ? ~0ull : ((rel < 0) ? 0ull : ((2ull << rel) - 1ull)); }
            else word = ((selmask >> blk) & 1u) ? ~0ull : 0ull; }
        if (__all(word == 0ull)) continue;
        const bool nearT = (qw0 - (64 * t + 63)) < 113;
        const float cinit = nearT ? 0.f : biasfar;
        f32x16 p0, p1;
#pragma unroll
        for (int r = 0; r < 16; ++r) { p0[r] = cinit; p1[r] = cinit; }
        { const LAS unsigned char* Kb = lds + buf + r32 * 128;
#pragma unroll
          for (int d0 = 0; d0 < 4; ++d0) {
              const int ch = ((2 * d0 + hi) ^ (r32 & 7)) << 4;
              const bf16x8 ka = *(const LAS bf16x8*)(Kb + ch), kb2 = *(const LAS bf16x8*)(Kb + 4096 + ch);
              p0 = MFMA32(ka, qf[d0], p0); p1 = MFMA32(kb2, qf[d0], p1); } }
        const unsigned wlo = (unsigned)word, whi = (unsigned)(word >> 32);
        if (nearT) {
            const int dbase = q - 64 * t;
#pragma unroll
            for (int r = 0; r < 16; ++r) { const int d0_ = dbase - crow(r, hi), d1_ = d0_ - 32;
                p0[r] += biasT[d0_ < 0 ? 0 : (d0_ > 127 ? 127 : d0_)]; p1[r] += biasT[d1_ < 0 ? 0 : (d1_ > 127 ? 127 : d1_)]; }
        }
#pragma unroll
        for (int r = 0; r < 16; ++r) { const int kv = crow(r, hi);
            if (!((wlo >> kv) & 1u)) p0[r] = -INFINITY; if (!((whi >> kv) & 1u)) p1[r] = -INFINITY; }
        float mx = fmaxf(p0[0], p1[0]);
#pragma unroll
        for (int r = 1; r < 16; ++r) mx = fmaxf(mx, fmaxf(p0[r], p1[r]));
        mx = fmaxf(mx, __shfl_xor(mx, 32));
        const float mnew = fmaxf(mrun, mx), alpha = __builtin_amdgcn_exp2f(mrun - mnew);
        mrun = mnew;
        float ls = 0.f;
#pragma unroll
        for (int r = 0; r < 16; ++r) { p0[r] = __builtin_amdgcn_exp2f(p0[r] - mnew); p1[r] = __builtin_amdgcn_exp2f(p1[r] - mnew); ls += p0[r] + p1[r]; o0[r] *= alpha; o1[r] *= alpha; }
        lrun = lrun * alpha + ls;
        bf16x8 pf[4];
        { v4u a; a.x = cvtpk(p0[0], p0[1]); a.y = cvtpk(p0[2], p0[3]); a.z = cvtpk(p0[4], p0[5]); a.w = cvtpk(p0[6], p0[7]); pf[0] = __builtin_bit_cast(bf16x8, a);
          a.x = cvtpk(p0[8], p0[9]); a.y = cvtpk(p0[10], p0[11]); a.z = cvtpk(p0[12], p0[13]); a.w = cvtpk(p0[14], p0[15]); pf[1] = __builtin_bit_cast(bf16x8, a);
          a.x = cvtpk(p1[0], p1[1]); a.y = cvtpk(p1[2], p1[3]); a.z = cvtpk(p1[4], p1[5]); a.w = cvtpk(p1[6], p1[7]); pf[2] = __builtin_bit_cast(bf16x8, a);
          a.x = cvtpk(p1[8], p1[9]); a.y = cvtpk(p1[10], p1[11]); a.z = cvtpk(p1[12], p1[13]); a.w = cvtpk(p1[14], p1[15]); pf[3] = __builtin_bit_cast(bf16x8, a); }
        { const LAS unsigned char* Vb = lds + 16384 + buf + r32 * 128 + 8 * hi;
#pragma unroll
          for (int ks = 0; ks < 4; ++ks) {
              const int c0 = 2 * ks;
              const int ca = ((c0 ^ (r32 & 7)) << 4), cb = (((c0 + 1) ^ (r32 & 7)) << 4);
              const s16x4 a0 = *(const LAS s16x4*)(Vb + ca), a1 = *(const LAS s16x4*)(Vb + cb);
              const s16x4 b0 = *(const LAS s16x4*)(Vb + 4096 + ca), b1 = *(const LAS s16x4*)(Vb + 4096 + cb);
              const bf16x8 va = __builtin_shufflevector(a0, a1, 0, 1, 2, 3, 4, 5, 6, 7), vb = __builtin_shufflevector(b0, b1, 0, 1, 2, 3, 4, 5, 6, 7);
              o0 = MFMA32(va, pf[ks], o0); o1 = MFMA32(vb, pf[ks], o1); } }
    }
    lrun += __shfl_xor(lrun, 32);
    const float rl = 1.0f / lrun;
    bf16* orow = MIX + (rb + q) * DM + 512 + h8 * 64 + 4 * hi;
#pragma unroll
    for (int g = 0; g < 4; ++g) {
        v2u a; a.x = pk2(o0[4 * g] * rl, o0[4 * g + 1] * rl); a.y = pk2(o0[4 * g + 2] * rl, o0[4 * g + 3] * rl); *(v2u*)(orow + 8 * g) = a;
        v2u c; c.x = pk2(o1[4 * g] * rl, o1[4 * g + 1] * rl); c.y = pk2(o1[4 * g + 2] * rl, o1[4 * g + 3] * rl); *(v2u*)(orow + 32 + 8 * g) = c;
    }
    __syncthreads();
}
__device__ __forceinline__ void phase_attn(const Frame& F) {
    { LAS float* bt = (LAS float*)(F.lds + 32768); const float* rbias = F.in[IN_RELB];
      const int th[16] = {16, 19, 21, 24, 27, 31, 35, 40, 46, 52, 59, 67, 77, 87, 99, 113};
      for (int i = F.tid; i < 8 * 128; i += NTHREADS) { const int h = i >> 7, d = i & 127; int bk = d;
          if (d >= 16) { bk = 15;
#pragma unroll
              for (int k = 0; k < 16; ++k) bk += (d >= th[k]) ? 1 : 0; }
          bt[i] = rbias[h * 32 + bk] * LOG2E; }
      __syncthreads(); }
    for (int pi = F.vcu; pi < 256; pi += F.G) { const int bh = pi >> 3, s = pi & 7; attn_unit(F, bh >> 3, bh & 7, s); attn_unit(F, bh >> 3, bh & 7, 15 - s); }
}

constexpr int NPHASES = 1 + 9 * DEPTH;
#ifndef PH_MASK
#define PH_MASK 0x3ff
#endif
#define PHM(k) ((PH_MASK >> (k)) & 1)
#ifndef MK_ONE_LAUNCH
#define MK_ONE_LAUNCH 0
#endif
__device__ __forceinline__ Frame relaunder(const Frame& F0) {
    Frame F = F0; int t; asm volatile("v_mbcnt_lo_u32_b32 %0, -1, 0\n\tv_mbcnt_hi_u32_b32 %0, -1, %0\n\tv_lshl_add_u32 %0, %1, 6, %0" : "=&v"(t) : "s"(F0.wave)); F.tid = t; F.lane = t & 63; F.wave = __builtin_amdgcn_readfirstlane(t >> 6);
    asm volatile("" : "+s"(F.ws)); asm volatile("" : "+s"(F.X)); asm volatile("" : "+s"(F.G)); asm volatile("" : "+s"(F.vcu)); asm volatile("" : "+s"(F.bx));
    return F; }
__global__ void __launch_bounds__(NTHREADS, 2) fwd(Args args) {
    extern __shared__ __attribute__((aligned(16))) unsigned char lds_raw[];
    Frame F;
    F.lds = (LAS unsigned char*)lds_raw;
    F.tid = threadIdx.x; F.lane = F.tid & 63; F.wave = __builtin_amdgcn_readfirstlane(F.tid >> 6);
    F.G = gridDim.x; F.bx = blockIdx.x; { const int bx = blockIdx.x; F.vcu = (F.G % 8 == 0) ? (bx % 8) * (F.G / 8) + bx / 8 : bx; }
    F.in = args.in; F.X = args.out; F.ws = args.ws;
    if (F.tid < 4) ((LAS unsigned*)(F.lds + MISC_OFF))[F.tid] = 0u;
    __syncthreads();
    const int lo = args.ph_lo, hi = args.ph_hi;
    if (hi - lo > 1) (void)xcd_barrier_post((unsigned*)(args.ws + WS_CTL), (volatile LAS unsigned*)(F.lds + MISC_OFF));
#define IN(k) (lo <= (k) && (k) < hi)
#define SEAM(k) do { if (IN(k) && IN((k) + 1)) { unsigned char* wsb = args.ws; asm volatile("" : "+s"(wsb)); XcdBarrier b_; b_.bar = (unsigned*)(wsb + WS_CTL); b_.x = xb_xcc_id(); b_.st = (volatile LAS unsigned*)(F.lds + MISC_OFF); xcd_barrier(b_); } } while (0)
    unsigned char* const ws = args.ws;
    if (PHM(0) && IN(0)) { const Frame Fl = relaunder(F); phase_prologue(Fl); }
    SEAM(0);

    { constexpr int L = 0;
    {
        const int p0 = 1 + 9 * L;
        unsigned char* wl = ws + WS_W + (size_t)L * LW_BYTES;
        if (PHM(1) && IN(p0 + 0)) {
            const Frame Fl = relaunder(F); unsigned char* const wsl = Fl.ws; unsigned char* const wll = wsl + WS_W + (size_t)L * LW_BYTES; pg8::Gemm g{(const bf16*)(wsl + WS_XB), (const bf16*)(wll + LW_WIN), M, ZP, DM}; pg8::StaticOrder S; S.init(M, ZP, Fl.G, Fl.bx);
            EpiZ E{(bf16*)(wsl + WS_RZ), (const float*)(wsl + WS_RSSPX)};
            pg8::gemm_phase<EpiZ, pg8::StaticOrder, true, true>(F.lds, g, S, E, Fl.tid);
        }
        SEAM(p0 + 0);
        if (PHM(2) && IN(p0 + 1)) { { const Frame Fl = relaunder(F); phase_index(Fl); } { const Frame Fl = relaunder(F); phase_prep(Fl, L); } }
        SEAM(p0 + 1);
        if (PHM(3) && IN(p0 + 2)) { const Frame Fl = relaunder(F); phase_attn(Fl); }
        SEAM(p0 + 2);
        if (PHM(4) && IN(p0 + 3)) {
            const Frame Fl = relaunder(F); unsigned char* const wsl = Fl.ws; unsigned char* const wll = wsl + WS_W + (size_t)L * LW_BYTES; pg8::Gemm g{(const bf16*)(wsl + WS_RM), (const bf16*)(wll + LW_WOUT), M, DM, DM}; pg8::StaticOrder S; S.init(M, DM, Fl.G, Fl.bx);
            EpiT E{(bf16*)(wsl + WS_RZ), (float*)(wsl + WS_RSSPT)};
            pg8::gemm_phase<EpiT, pg8::StaticOrder, true, true>(F.lds, g, S, E, Fl.tid);
        }
        SEAM(p0 + 3);
        if (PHM(5) && IN(p0 + 4)) { const Frame Fl = relaunder(F); phase_resid(Fl, (const bf16*)(Fl.ws + WS_RZ), (const float*)(Fl.ws + WS_RSSPT), Fl.in[IN_GMIXPOST] + L * DM); }
        SEAM(p0 + 4);
        if (PHM(6) && IN(p0 + 5)) {
            const Frame Fl = relaunder(F); unsigned char* const wsl = Fl.ws; unsigned char* const wll = wsl + WS_W + (size_t)L * LW_BYTES; pg8::Gemm g{(const bf16*)(wsl + WS_XB), (const bf16*)(wll + LW_WGU), M, 2 * DFF, DM}; pg8::StaticOrder S; S.init(M, 2 * DFF, Fl.G, Fl.bx);
            EpiSwiGLU E{(bf16*)(wsl + WS_RZ), (const float*)(wsl + WS_RSS1)};
            pg8::gemm_phase<EpiSwiGLU, pg8::StaticOrder, true, true>(F.lds, g, S, E, Fl.tid);
        }
        SEAM(p0 + 5);
        if (PHM(7) && IN(p0 + 6)) {
            { const Frame Fl = relaunder(F); unsigned char* const wsl = Fl.ws; unsigned char* const wll = wsl + WS_W + (size_t)L * LW_BYTES; pg8::Gemm g{(const bf16*)(wsl + WS_RZ), (const bf16*)(wll + LW_WD), M, DM, DFF}; pg8::StaticOrder S; S.init(M, DM, Fl.G, Fl.bx);
              EpiT E{(bf16*)(wsl + WS_RM), (float*)(wsl + WS_RSSPT)};
              pg8::gemm_phase<EpiT, pg8::StaticOrder, true, true>(F.lds, g, S, E, Fl.tid); }
            __syncthreads();
            { const Frame Fl = relaunder(F); unsigned char* const wsl = Fl.ws; unsigned char* const wll = wsl + WS_W + (size_t)L * LW_BYTES; pg8::Gemm g{(const bf16*)(wsl + WS_PB) + (size_t)L * M * PLE, (const bf16*)(wll + LW_WP), M, DM, PLE}; pg8::StaticOrder S; S.init(M, DM, Fl.G, Fl.bx);
              EpiB E{(bf16*)(wsl + WS_RV)};
              pg8::gemm_phase<EpiB, pg8::StaticOrder, true, true>(F.lds, g, S, E, Fl.tid); }
        }
        SEAM(p0 + 6);
        if (PHM(8) && IN(p0 + 7)) { const Frame Fl = relaunder(F); phase_resid(Fl, (const bf16*)(Fl.ws + WS_RM), (const float*)(Fl.ws + WS_RSSPT), Fl.in[IN_GFFNPOST] + L * DM); }
        SEAM(p0 + 7);
        if (PHM(9) && IN(p0 + 8)) {
            const Frame Fl = relaunder(F); unsigned char* const wsl = Fl.ws; unsigned char* const wll = wsl + WS_W + (size_t)L * LW_BYTES; pg8::Gemm g{(const bf16*)(wsl + WS_XB), (const bf16*)(wll + LW_WG), M, DM, DM}; pg8::StaticOrder S; S.init(M, DM, Fl.G, Fl.bx);
            EpiPLE E{Fl.X, (bf16*)(wsl + WS_XB), (const bf16*)(wsl + WS_RV), (const float*)(wsl + WS_RSS1), (float*)(wsl + WS_RSSPX)};
            pg8::gemm_phase<EpiPLE, pg8::StaticOrder, true, true>(F.lds, g, S, E, Fl.tid);
        }
        SEAM(p0 + 8);
    }
        }

    { constexpr int L = 1;
    {
        const int p0 = 1 + 9 * L;
        unsigned char* wl = ws + WS_W + (size_t)L * LW_BYTES;
        if (PHM(1) && IN(p0 + 0)) {
            const Frame Fl = relaunder(F); unsigned char* const wsl = Fl.ws; unsigned char* const wll = wsl + WS_W + (size_t)L * LW_BYTES; pg8::Gemm g{(const bf16*)(wsl + WS_XB), (const bf16*)(wll + LW_WIN), M, ZP, DM}; pg8::StaticOrder S; S.init(M, ZP, Fl.G, Fl.bx);
            EpiZ E{(bf16*)(wsl + WS_RZ), (const float*)(wsl + WS_RSSPX)};
            pg8::gemm_phase<EpiZ, pg8::StaticOrder, true, true>(F.lds, g, S, E, Fl.tid);
        }
        SEAM(p0 + 0);
        if (PHM(2) && IN(p0 + 1)) { { const Frame Fl = relaunder(F); phase_index(Fl); } { const Frame Fl = relaunder(F); phase_prep(Fl, L); } }
        SEAM(p0 + 1);
        if (PHM(3) && IN(p0 + 2)) { const Frame Fl = relaunder(F); phase_attn(Fl); }
        SEAM(p0 + 2);
        if (PHM(4) && IN(p0 + 3)) {
            const Frame Fl = relaunder(F); unsigned char* const wsl = Fl.ws; unsigned char* const wll = wsl + WS_W + (size_t)L * LW_BYTES; pg8::Gemm g{(const bf16*)(wsl + WS_RM), (const bf16*)(wll + LW_WOUT), M, DM, DM}; pg8::StaticOrder S; S.init(M, DM, Fl.G, Fl.bx);
            EpiT E{(bf16*)(wsl + WS_RZ), (float*)(wsl + WS_RSSPT)};
            pg8::gemm_phase<EpiT, pg8::StaticOrder, true, true>(F.lds, g, S, E, Fl.tid);
        }
        SEAM(p0 + 3);
        if (PHM(5) && IN(p0 + 4)) { const Frame Fl = relaunder(F); phase_resid(Fl, (const bf16*)(Fl.ws + WS_RZ), (const float*)(Fl.ws + WS_RSSPT), Fl.in[IN_GMIXPOST] + L * DM); }
        SEAM(p0 + 4);
        if (PHM(6) && IN(p0 + 5)) {
            const Frame Fl = relaunder(F); unsigned char* const wsl = Fl.ws; unsigned char* const wll = wsl + WS_W + (size_t)L * LW_BYTES; pg8::Gemm g{(const bf16*)(wsl + WS_XB), (const bf16*)(wll + LW_WGU), M, 2 * DFF, DM}; pg8::StaticOrder S; S.init(M, 2 * DFF, Fl.G, Fl.bx);
            EpiSwiGLU E{(bf16*)(wsl + WS_RZ), (const float*)(wsl + WS_RSS1)};
            pg8::gemm_phase<EpiSwiGLU, pg8::StaticOrder, true, true>(F.lds, g, S, E, Fl.tid);
        }
        SEAM(p0 + 5);
        if (PHM(7) && IN(p0 + 6)) {
            { const Frame Fl = relaunder(F); unsigned char* const wsl = Fl.ws; unsigned char* const wll = wsl + WS_W + (size_t)L * LW_BYTES; pg8::Gemm g{(const bf16*)(wsl + WS_RZ), (const bf16*)(wll + LW_WD), M, DM, DFF}; pg8::StaticOrder S; S.init(M, DM, Fl.G, Fl.bx);
              EpiT E{(bf16*)(wsl + WS_RM), (float*)(wsl + WS_RSSPT)};
              pg8::gemm_phase<EpiT, pg8::StaticOrder, true, true>(F.lds, g, S, E, Fl.tid); }
            __syncthreads();
            { const Frame Fl = relaunder(F); unsigned char* const wsl = Fl.ws; unsigned char* const wll = wsl + WS_W + (size_t)L * LW_BYTES; pg8::Gemm g{(const bf16*)(wsl + WS_PB) + (size_t)L * M * PLE, (const bf16*)(wll + LW_WP), M, DM, PLE}; pg8::StaticOrder S; S.init(M, DM, Fl.G, Fl.bx);
              EpiB E{(bf16*)(wsl + WS_RV)};
              pg8::gemm_phase<EpiB, pg8::StaticOrder, true, true>(F.lds, g, S, E, Fl.tid); }
        }
        SEAM(p0 + 6);
        if (PHM(8) && IN(p0 + 7)) { const Frame Fl = relaunder(F); phase_resid(Fl, (const bf16*)(Fl.ws + WS_RM), (const float*)(Fl.ws + WS_RSSPT), Fl.in[IN_GFFNPOST] + L * DM); }
        SEAM(p0 + 7);
        if (PHM(9) && IN(p0 + 8)) {
            const Frame Fl = relaunder(F); unsigned char* const wsl = Fl.ws; unsigned char* const wll = wsl + WS_W + (size_t)L * LW_BYTES; pg8::Gemm g{(const bf16*)(wsl + WS_XB), (const bf16*)(wll + LW_WG), M, DM, DM}; pg8::StaticOrder S; S.init(M, DM, Fl.G, Fl.bx);
            EpiPLE E{Fl.X, (bf16*)(wsl + WS_XB), (const bf16*)(wsl + WS_RV), (const float*)(wsl + WS_RSS1), (float*)(wsl + WS_RSSPX)};
            pg8::gemm_phase<EpiPLE, pg8::StaticOrder, true, true>(F.lds, g, S, E, Fl.tid);
        }
        SEAM(p0 + 8);
    }
        }

    { constexpr int L = 2;
    {
        const int p0 = 1 + 9 * L;
        unsigned char* wl = ws + WS_W + (size_t)L * LW_BYTES;
        if (PHM(1) && IN(p0 + 0)) {
            const Frame Fl = relaunder(F); unsigned char* const wsl = Fl.ws; unsigned char* const wll = wsl + WS_W + (size_t)L * LW_BYTES; pg8::Gemm g{(const bf16*)(wsl + WS_XB), (const bf16*)(wll + LW_WIN), M, ZP, DM}; pg8::StaticOrder S; S.init(M, ZP, Fl.G, Fl.bx);
            EpiZ E{(bf16*)(wsl + WS_RZ), (const float*)(wsl + WS_RSSPX)};
            pg8::gemm_phase<EpiZ, pg8::StaticOrder, true, true>(F.lds, g, S, E, Fl.tid);
        }
        SEAM(p0 + 0);
        if (PHM(2) && IN(p0 + 1)) { { const Frame Fl = relaunder(F); phase_index(Fl); } { const Frame Fl = relaunder(F); phase_prep(Fl, L); } }
        SEAM(p0 + 1);
        if (PHM(3) && IN(p0 + 2)) { const Frame Fl = relaunder(F); phase_attn(Fl); }
        SEAM(p0 + 2);
        if (PHM(4) && IN(p0 + 3)) {
            const Frame Fl = relaunder(F); unsigned char* const wsl = Fl.ws; unsigned char* const wll = wsl + WS_W + (size_t)L * LW_BYTES; pg8::Gemm g{(const bf16*)(wsl + WS_RM), (const bf16*)(wll + LW_WOUT), M, DM, DM}; pg8::StaticOrder S; S.init(M, DM, Fl.G, Fl.bx);
            EpiT E{(bf16*)(wsl + WS_RZ), (float*)(wsl + WS_RSSPT)};
            pg8::gemm_phase<EpiT, pg8::StaticOrder, true, true>(F.lds, g, S, E, Fl.tid);
        }
        SEAM(p0 + 3);
        if (PHM(5) && IN(p0 + 4)) { const Frame Fl = relaunder(F); phase_resid(Fl, (const bf16*)(Fl.ws + WS_RZ), (const float*)(Fl.ws + WS_RSSPT), Fl.in[IN_GMIXPOST] + L * DM); }
        SEAM(p0 + 4);
        if (PHM(6) && IN(p0 + 5)) {
            const Frame Fl = relaunder(F); unsigned char* const wsl = Fl.ws; unsigned char* const wll = wsl + WS_W + (size_t)L * LW_BYTES; pg8::Gemm g{(const bf16*)(wsl + WS_XB), (const bf16*)(wll + LW_WGU), M, 2 * DFF, DM}; pg8::StaticOrder S; S.init(M, 2 * DFF, Fl.G, Fl.bx);
            EpiSwiGLU E{(bf16*)(wsl + WS_RZ), (const float*)(wsl + WS_RSS1)};
            pg8::gemm_phase<EpiSwiGLU, pg8::StaticOrder, true, true>(F.lds, g, S, E, Fl.tid);
        }
        SEAM(p0 + 5);
        if (PHM(7) && IN(p0 + 6)) {
            { const Frame Fl = relaunder(F); unsigned char* const wsl = Fl.ws; unsigned char* const wll = wsl + WS_W + (size_t)L * LW_BYTES; pg8::Gemm g{(const bf16*)(wsl + WS_RZ), (const bf16*)(wll + LW_WD), M, DM, DFF}; pg8::StaticOrder S; S.init(M, DM, Fl.G, Fl.bx);
              EpiT E{(bf16*)(wsl + WS_RM), (float*)(wsl + WS_RSSPT)};
              pg8::gemm_phase<EpiT, pg8::StaticOrder, true, true>(F.lds, g, S, E, Fl.tid); }
            __syncthreads();
            { const Frame Fl = relaunder(F); unsigned char* const wsl = Fl.ws; unsigned char* const wll = wsl + WS_W + (size_t)L * LW_BYTES; pg8::Gemm g{(const bf16*)(wsl + WS_PB) + (size_t)L * M * PLE, (const bf16*)(wll + LW_WP), M, DM, PLE}; pg8::StaticOrder S; S.init(M, DM, Fl.G, Fl.bx);
              EpiB E{(bf16*)(wsl + WS_RV)};
              pg8::gemm_phase<EpiB, pg8::StaticOrder, true, true>(F.lds, g, S, E, Fl.tid); }
        }
        SEAM(p0 + 6);
        if (PHM(8) && IN(p0 + 7)) { const Frame Fl = relaunder(F); phase_resid(Fl, (const bf16*)(Fl.ws + WS_RM), (const float*)(Fl.ws + WS_RSSPT), Fl.in[IN_GFFNPOST] + L * DM); }
        SEAM(p0 + 7);
        if (PHM(9) && IN(p0 + 8)) {
            const Frame Fl = relaunder(F); unsigned char* const wsl = Fl.ws; unsigned char* const wll = wsl + WS_W + (size_t)L * LW_BYTES; pg8::Gemm g{(const bf16*)(wsl + WS_XB), (const bf16*)(wll + LW_WG), M, DM, DM}; pg8::StaticOrder S; S.init(M, DM, Fl.G, Fl.bx);
            EpiPLE E{Fl.X, (bf16*)(wsl + WS_XB), (const bf16*)(wsl + WS_RV), (const float*)(wsl + WS_RSS1), (float*)(wsl + WS_RSSPX)};
            pg8::gemm_phase<EpiPLE, pg8::StaticOrder, true, true>(F.lds, g, S, E, Fl.tid);
        }
        SEAM(p0 + 8);
    }
        }

    { constexpr int L = 3;
    {
        const int p0 = 1 + 9 * L;
        unsigned char* wl = ws + WS_W + (size_t)L * LW_BYTES;
        if (PHM(1) && IN(p0 + 0)) {
            const Frame Fl = relaunder(F); unsigned char* const wsl = Fl.ws; unsigned char* const wll = wsl + WS_W + (size_t)L * LW_BYTES; pg8::Gemm g{(const bf16*)(wsl + WS_XB), (const bf16*)(wll + LW_WIN), M, ZP, DM}; pg8::StaticOrder S; S.init(M, ZP, Fl.G, Fl.bx);
            EpiZ E{(bf16*)(wsl + WS_RZ), (const float*)(wsl + WS_RSSPX)};
            pg8::gemm_phase<EpiZ, pg8::StaticOrder, true, true>(F.lds, g, S, E, Fl.tid);
        }
        SEAM(p0 + 0);
        if (PHM(2) && IN(p0 + 1)) { { const Frame Fl = relaunder(F); phase_index(Fl); } { const Frame Fl = relaunder(F); phase_prep(Fl, L); } }
        SEAM(p0 + 1);
        if (PHM(3) && IN(p0 + 2)) { const Frame Fl = relaunder(F); phase_attn(Fl); }
        SEAM(p0 + 2);
        if (PHM(4) && IN(p0 + 3)) {
            const Frame Fl = relaunder(F); unsigned char* const wsl = Fl.ws; unsigned char* const wll = wsl + WS_W + (size_t)L * LW_BYTES; pg8::Gemm g{(const bf16*)(wsl + WS_RM), (const bf16*)(wll + LW_WOUT), M, DM, DM}; pg8::StaticOrder S; S.init(M, DM, Fl.G, Fl.bx);
            EpiT E{(bf16*)(wsl + WS_RZ), (float*)(wsl + WS_RSSPT)};
            pg8::gemm_phase<EpiT, pg8::StaticOrder, true, true>(F.lds, g, S, E, Fl.tid);
        }
        SEAM(p0 + 3);
        if (PHM(5) && IN(p0 + 4)) { const Frame Fl = relaunder(F); phase_resid(Fl, (const bf16*)(Fl.ws + WS_RZ), (const float*)(Fl.ws + WS_RSSPT), Fl.in[IN_GMIXPOST] + L * DM); }
        SEAM(p0 + 4);
        if (PHM(6) && IN(p0 + 5)) {
            const Frame Fl = relaunder(F); unsigned char* const wsl = Fl.ws; unsigned char* const wll = wsl + WS_W + (size_t)L * LW_BYTES; pg8::Gemm g{(const bf16*)(wsl + WS_XB), (const bf16*)(wll + LW_WGU), M, 2 * DFF, DM}; pg8::StaticOrder S; S.init(M, 2 * DFF, Fl.G, Fl.bx);
            EpiSwiGLU E{(bf16*)(wsl + WS_RZ), (const float*)(wsl + WS_RSS1)};
            pg8::gemm_phase<EpiSwiGLU, pg8::StaticOrder, true, true>(F.lds, g, S, E, Fl.tid);
        }
        SEAM(p0 + 5);
        if (PHM(7) && IN(p0 + 6)) {
            { const Frame Fl = relaunder(F); unsigned char* const wsl = Fl.ws; unsigned char* const wll = wsl + WS_W + (size_t)L * LW_BYTES; pg8::Gemm g{(const bf16*)(wsl + WS_RZ), (const bf16*)(wll + LW_WD), M, DM, DFF}; pg8::StaticOrder S; S.init(M, DM, Fl.G, Fl.bx);
              EpiT E{(bf16*)(wsl + WS_RM), (float*)(wsl + WS_RSSPT)};
              pg8::gemm_phase<EpiT, pg8::StaticOrder, true, true>(F.lds, g, S, E, Fl.tid); }
            __syncthreads();
            { const Frame Fl = relaunder(F); unsigned char* const wsl = Fl.ws; unsigned char* const wll = wsl + WS_W + (size_t)L * LW_BYTES; pg8::Gemm g{(const bf16*)(wsl + WS_PB) + (size_t)L * M * PLE, (const bf16*)(wll + LW_WP), M, DM, PLE}; pg8::StaticOrder S; S.init(M, DM, Fl.G, Fl.bx);
              EpiB E{(bf16*)(wsl + WS_RV)};
              pg8::gemm_phase<EpiB, pg8::StaticOrder, true, true>(F.lds, g, S, E, Fl.tid); }
        }
        SEAM(p0 + 6);
        if (PHM(8) && IN(p0 + 7)) { const Frame Fl = relaunder(F); phase_resid(Fl, (const bf16*)(Fl.ws + WS_RM), (const float*)(Fl.ws + WS_RSSPT), Fl.in[IN_GFFNPOST] + L * DM); }
        SEAM(p0 + 7);
        if (PHM(9) && IN(p0 + 8)) {
            const Frame Fl = relaunder(F); unsigned char* const wsl = Fl.ws; unsigned char* const wll = wsl + WS_W + (size_t)L * LW_BYTES; pg8::Gemm g{(const bf16*)(wsl + WS_XB), (const bf16*)(wll + LW_WG), M, DM, DM}; pg8::StaticOrder S; S.init(M, DM, Fl.G, Fl.bx);
            EpiPLE E{Fl.X, (bf16*)(wsl + WS_XB), (const bf16*)(wsl + WS_RV), (const float*)(wsl + WS_RSS1), (float*)(wsl + WS_RSSPX)};
            pg8::gemm_phase<EpiPLE, pg8::StaticOrder, true, true>(F.lds, g, S, E, Fl.tid);
        }
        SEAM(p0 + 8);
    }
        }

#undef IN
#undef SEAM
}

extern "C" void kernel_launch(void* const* d_in, const int* in_sizes, int n_in, void* d_out, int out_size, void* d_ws, size_t ws_size, hipStream_t stream) {
    static int grid = 0;
    if (grid == 0) {
        if (n_in != 17 || in_sizes[0] != M * DM || out_size != M * DM || ws_size < WS_END) {
            fprintf(stderr, "kernel_launch: unexpected problem (n_in %d, in0 %d, out %d, ws %zu < %zu); nothing launched\n", n_in, n_in > 0 ? in_sizes[0] : -1, out_size, ws_size, (size_t)WS_END); grid = -1; return; }
        int dev = 0, cus = 0, per_cu = 0;
        if (hipGetDevice(&dev) != hipSuccess || hipDeviceGetAttribute(&cus, hipDeviceAttributeMultiprocessorCount, dev) != hipSuccess) { grid = -1; return; }
        if (hipFuncSetAttribute((const void*)fwd, hipFuncAttributeMaxDynamicSharedMemorySize, LDS_BYTES) != hipSuccess) { fprintf(stderr, "kernel_launch: hipFuncSetAttribute failed\n"); grid = -1; return; }
        if (hipOccupancyMaxActiveBlocksPerMultiprocessor(&per_cu, (const void*)fwd, NTHREADS, LDS_BYTES) != hipSuccess || per_cu < 1)
            fprintf(stderr, "kernel_launch: occupancy query reports %d workgroups per CU\n", per_cu);
        (void)hipGetLastError();
        grid = cus;
    }
    if (grid < 0) return;
    if (hipMemsetAsync((char*)d_ws + WS_CTL, 0, CTL_ZERO_BYTES, stream) != hipSuccess) return;
    Args a{};
    for (int i = 0; i < 17; ++i) a.in[i] = (const float*)d_in[i];
    a.out = (float*)d_out; a.ws = (unsigned char*)d_ws;
#if MK_ONE_LAUNCH
    a.ph_lo = 0; a.ph_hi = NPHASES;
    hipLaunchKernelGGL(fwd, dim3(grid), dim3(NTHREADS), LDS_BYTES, stream, a);
#else
    for (int p = 0; p < NPHASES; ++p) { a.ph_lo = p; a.ph_hi = p + 1; hipLaunchKernelGGL(fwd, dim3(grid), dim3(NTHREADS), LDS_BYTES, stream, a); }
#endif
}
```

```cpp
#include <hip/hip_runtime.h>
#include <cstdio>
#include <cstdint>
namespace pg8 {
#define PG8_LAS __attribute__((address_space(3)))
typedef unsigned short bf16_t;
typedef short bf16x8 __attribute__((ext_vector_type(8)));
typedef float f32x4 __attribute__((ext_vector_type(4)));
typedef unsigned u32x4 __attribute__((ext_vector_type(4)));
constexpr int BM = 256, BK = 64, HALF = 128, HTB = HALF * BK * 2  , STAGE_BYTES = 8 * HTB, NXCD = 8, WGM = 8;

__host__ __device__ __forceinline__ int lds_byte(int r, int c) { const int st = (r >> 4) * 2 + (c >> 5), rr = r & 15, cc = c & 31, ob = rr * 64 + cc * 2; return st * 1024 + (ob ^ (((ob >> 9) & 1) << 5)); }
__host__ __device__ __forceinline__ void stage_rc(int b, int& R, int& C) { const int st = b / 1024, sb = b % 1024, swz = sb ^ (((sb >> 9) & 1) << 5); R = (st >> 1) * 16 + swz / 64; C = (st & 1) * 32 + (swz % 64) / 2; }
__host__ __device__ __forceinline__ int perm32(int rho) { const int n = rho >> 4, i = rho & 15; return 8 * (i >> 2) + 4 * n + (i & 3); }

struct Unit { int pm, pn; };
struct Gemm { const bf16_t* A; const bf16_t* Bt; int M, N, K; };

struct StaticOrder {
    int nM, nN, nwg, G, c;
    __host__ __device__ void init(int M, int N, int G_, int c_) { nM = M / BM; nN = N / BM; nwg = nM * nN; G = G_; c = c_; }
    __host__ __device__ bool next(int i, Unit& u) const {
        const long L = (long)i * G + c; if (L >= nwg) return false;
        int wgid = (int)L; { const int q = nwg / NXCD, r = nwg % NXCD, xcd = wgid % NXCD, off = wgid / NXCD; wgid = (xcd < r ? xcd * (q + 1) : r * (q + 1) + (xcd - r) * q) + off; }
        const int nig = WGM * nN, gid = wgid / nig, fm = gid * WGM, gsz = (nM - fm) < WGM ? (nM - fm) : WGM;
        u.pm = fm + ((wgid % nig) % gsz); u.pn = (wgid % nig) / gsz; return true;
    }
    __device__ __forceinline__ void a_ready(const Unit&) const {}
    __device__ __forceinline__ void done(const Unit&) const {}
};

template <class Epi, class Sched, bool ALIGN_EPI = false, bool SP2 = false>
__device__ __forceinline__ void gemm_phase(PG8_LAS unsigned char* lds, const Gemm g, const Sched& S, const Epi& E, int tid_in) {
    int tid_l = tid_in; asm volatile("" : "+v"(tid_l)); const int tid = tid_l, wid = __builtin_amdgcn_readfirstlane(tid >> 6), lane = tid & 63, wr = wid >> 2, wc = wid & 3, fr = lane & 15, fq = lane >> 4;
    const int K = g.K, nt = K / BK;
    unsigned voffA[2], voffB[2];
#pragma unroll
    for (int i = 0; i < 2; ++i) { int R, C; stage_rc(tid * 16 + i * 8192, R, C); const int Rb = Epi::PERM ? ((R & ~31) + perm32(R & 31)) : R;
        voffA[i] = (unsigned)(R * K + C) * 2u; voffB[i] = (unsigned)(Rb * K + C) * 2u; }
    const size_t kstep = (size_t)(BK * 2);
    const size_t hstep = (size_t)HALF * K * 2;
    const size_t tstep = 2 * hstep;
    const unsigned ldsw = (unsigned)wid * 1024u;
    const int aoff = lds_byte(wr * 64 + fr, fq * 8), boff = lds_byte(wc * 32 + fr, fq * 8);
#define PG8_SA(b, h) (((b) * 2 + (h)) * HTB)
#define PG8_SB(b, h) ((4 + (b) * 2 + (h)) * HTB)
#define PG8_STAGE(bufoff, gbase, voff) do { _Pragma("unroll") for (int _i = 0; _i < 2; ++_i) \
        __builtin_amdgcn_global_load_lds((const unsigned*)((const char*)(gbase) + (voff)[_i]), (PG8_LAS unsigned*)(lds + (bufoff) + ldsw + _i * 8192), 16, 0, 0); } while (0)
#define PG8_LDA(dst, b, h) do { _Pragma("unroll") for (int m = 0; m < 4; ++m) _Pragma("unroll") for (int k = 0; k < 2; ++k) dst[m][k] = *(const PG8_LAS bf16x8*)(lds + PG8_SA(b, h) + aoff + m * 2048 + k * 1024); } while (0)
#define PG8_LDB(dst, b, h) do { _Pragma("unroll") for (int n = 0; n < 2; ++n) _Pragma("unroll") for (int k = 0; k < 2; ++k) dst[n][k] = *(const PG8_LAS bf16x8*)(lds + PG8_SB(b, h) + boff + n * 2048 + k * 1024); } while (0)
#define PG8_MMA(ai, bj, At, Bt) do { __builtin_amdgcn_s_setprio(1); _Pragma("unroll") for (int m = 0; m < 4; ++m) _Pragma("unroll") for (int n = 0; n < 2; ++n) _Pragma("unroll") for (int k = 0; k < 2; ++k) \
        acc[ai][bj][m][n] = __builtin_amdgcn_mfma_f32_16x16x32_bf16(Bt[n][k], At[m][k], acc[ai][bj][m][n], 0, 0, 0); __builtin_amdgcn_s_setprio(0); } while (0)
#define PG8_WAIT_V(n) asm volatile("s_waitcnt vmcnt(" #n ")" ::: "memory")
#define PG8_WAIT_L(n) asm volatile("s_waitcnt lgkmcnt(" #n ")" ::: "memory")
#define PG8_BAR __builtin_amdgcn_s_barrier()
#define PG8_SCHED __builtin_amdgcn_sched_barrier(0)
    Unit cur, nxt; int ui = 0;
    if (!S.next(0, cur)) return;
    f32x4 acc[2][2][4][2];
#pragma unroll
    for (int a = 0; a < 2; ++a)
#pragma unroll
        for (int b = 0; b < 2; ++b)
#pragma unroll
            for (int m = 0; m < 4; ++m)
#pragma unroll
                for (int n = 0; n < 2; ++n) acc[a][b][m][n] = (f32x4){0.f, 0.f, 0.f, 0.f};
    bf16x8 At[4][2], B0[2][2], B1[2][2];
    const char* cA = (const char*)g.A + (size_t)cur.pm * tstep; const char* cB = (const char*)g.Bt + (size_t)cur.pn * tstep;
    S.a_ready(cur);
    if constexpr (SP2) {
        PG8_STAGE(PG8_SB(0, 0), cB, voffB); PG8_STAGE(PG8_SB(0, 1), cB + hstep, voffB); PG8_STAGE(PG8_SA(0, 0), cA, voffA); PG8_STAGE(PG8_SA(0, 1), cA + hstep, voffA);
        if (wr == 1) PG8_BAR;
        PG8_WAIT_V(2); PG8_BAR;
        PG8_STAGE(PG8_SB(1, 0), cB + kstep, voffB); PG8_STAGE(PG8_SA(1, 0), cA + kstep, voffA); PG8_STAGE(PG8_SB(1, 1), cB + hstep + kstep, voffB);
        PG8_WAIT_V(6); PG8_BAR;
    } else {
        PG8_STAGE(PG8_SB(0, 0), cB, voffB); PG8_STAGE(PG8_SA(0, 0), cA, voffA); PG8_STAGE(PG8_SB(0, 1), cB + hstep, voffB); PG8_STAGE(PG8_SA(0, 1), cA + hstep, voffA);
        if (wr == 1) PG8_BAR;
        PG8_WAIT_V(4); PG8_BAR;
        PG8_STAGE(PG8_SB(1, 0), cB + kstep, voffB); PG8_STAGE(PG8_SA(1, 0), cA + kstep, voffA); PG8_STAGE(PG8_SB(1, 1), cB + hstep + kstep, voffB);
        PG8_WAIT_V(6); PG8_BAR;
    }
    for (;;) {
        const bool has_next = S.next(ui + 1, nxt);
        const char* nA = has_next ? (const char*)g.A + (size_t)nxt.pm * tstep : cA; const char* nB = has_next ? (const char*)g.Bt + (size_t)nxt.pn * tstep : cB;
        for (int t = 0; t < nt; t += 2) {
            const bool last = (t == nt - 2);
            const char* a1 = cA + (size_t)(t + 1) * kstep;
            const char* a2 = last ? nA : cA + (size_t)(t + 2) * kstep; const char* b2 = last ? nB : cB + (size_t)(t + 2) * kstep;
            const char* a3 = a2 + kstep; const char* b3 = b2 + kstep;
            if (last && has_next) S.a_ready(nxt);
            if constexpr (SP2) {
            PG8_LDB(B0, 0, 0); PG8_LDB(B1, 0, 1); PG8_SCHED; PG8_LDA(At, 0, 0); PG8_STAGE(PG8_SA(1, 1), a1 + hstep, voffA);
            PG8_WAIT_V(8); PG8_WAIT_L(0); PG8_BAR; PG8_MMA(0, 0, At, B0); PG8_MMA(0, 1, At, B1); PG8_BAR; PG8_SCHED;
            PG8_LDA(At, 0, 1); PG8_STAGE(PG8_SB(0, 0), b2, voffB); PG8_STAGE(PG8_SB(0, 1), b2 + hstep, voffB); PG8_STAGE(PG8_SA(0, 0), a2, voffA);
            PG8_WAIT_V(8); PG8_WAIT_L(0); PG8_BAR; PG8_MMA(1, 0, At, B0); PG8_MMA(1, 1, At, B1); PG8_BAR; PG8_SCHED;
            PG8_LDB(B0, 1, 0); PG8_LDB(B1, 1, 1); PG8_SCHED; PG8_LDA(At, 1, 0); PG8_STAGE(PG8_SA(0, 1), a2 + hstep, voffA);
            PG8_WAIT_V(8); PG8_WAIT_L(0); PG8_BAR; PG8_MMA(0, 0, At, B0); PG8_MMA(0, 1, At, B1); PG8_BAR; PG8_SCHED;
            PG8_LDA(At, 1, 1); PG8_STAGE(PG8_SB(1, 0), b3, voffB); PG8_STAGE(PG8_SB(1, 1), b3 + hstep, voffB); PG8_STAGE(PG8_SA(1, 0), a3, voffA);
            PG8_WAIT_V(8); PG8_WAIT_L(0); PG8_BAR; PG8_MMA(1, 0, At, B0); PG8_MMA(1, 1, At, B1); PG8_BAR; PG8_SCHED;
            } else {
            PG8_LDB(B0, 0, 0); PG8_SCHED; PG8_LDA(At, 0, 0); PG8_STAGE(PG8_SA(1, 1), a1 + hstep, voffA);
            PG8_WAIT_L(8); PG8_BAR; PG8_WAIT_L(0); PG8_MMA(0, 0, At, B0); PG8_BAR; PG8_SCHED;
            PG8_LDB(B1, 0, 1); PG8_STAGE(PG8_SB(0, 0), b2, voffB);
            PG8_BAR; PG8_WAIT_L(0); PG8_MMA(0, 1, At, B1); PG8_BAR;
            PG8_LDA(At, 0, 1); PG8_STAGE(PG8_SA(0, 0), a2, voffA);
            PG8_BAR; PG8_WAIT_L(0); PG8_MMA(1, 0, At, B0); PG8_BAR; PG8_SCHED;
            PG8_STAGE(PG8_SB(0, 1), b2 + hstep, voffB);
            PG8_WAIT_V(6); PG8_BAR; PG8_MMA(1, 1, At, B1); PG8_BAR;
            PG8_LDB(B0, 1, 0); PG8_SCHED; PG8_LDA(At, 1, 0); PG8_STAGE(PG8_SA(0, 1), a2 + hstep, voffA);
            PG8_WAIT_L(8); PG8_BAR; PG8_WAIT_L(0); PG8_MMA(0, 0, At, B0); PG8_BAR; PG8_SCHED;
            PG8_LDB(B1, 1, 1); PG8_STAGE(PG8_SB(1, 0), b3, voffB);
            PG8_BAR; PG8_WAIT_L(0); PG8_MMA(0, 1, At, B1); PG8_BAR;
            PG8_LDA(At, 1, 1); PG8_STAGE(PG8_SA(1, 0), a3, voffA);
            PG8_BAR; PG8_WAIT_L(0); PG8_MMA(1, 0, At, B0); PG8_BAR; PG8_SCHED;
            PG8_STAGE(PG8_SB(1, 1), b3 + hstep, voffB);
            PG8_WAIT_V(6); PG8_BAR; PG8_MMA(1, 1, At, B1); PG8_BAR;
            }
        }
        if constexpr (ALIGN_EPI) { if (wr == 0) PG8_BAR; }
        if constexpr (!Epi::AFTER_DRAIN) { E(acc, cur, wr, wc, fr, fq); S.done(cur); }
        if (!has_next) break;
#pragma unroll
        for (int a = 0; a < 2; ++a)
#pragma unroll
            for (int b = 0; b < 2; ++b)
#pragma unroll
                for (int m = 0; m < 4; ++m)
#pragma unroll
                    for (int n = 0; n < 2; ++n) acc[a][b][m][n] = (f32x4){0.f, 0.f, 0.f, 0.f};
        cur = nxt; cA = nA; cB = nB; ++ui;
        if constexpr (ALIGN_EPI) { if (wr == 1) PG8_BAR; }
    }
    PG8_WAIT_V(0);
    if constexpr (!ALIGN_EPI) { if (wr == 0) PG8_BAR; }
    PG8_BAR;
    if constexpr (Epi::AFTER_DRAIN) { E.fused(acc, cur, wr, wc, fr, fq, lds, wid, lane); S.done(cur); }
#undef PG8_SA
#undef PG8_SB
#undef PG8_STAGE
#undef PG8_LDA
#undef PG8_LDB
#undef PG8_MMA
#undef PG8_WAIT_V
#undef PG8_WAIT_L
#undef PG8_BAR
#undef PG8_SCHED
}
}

constexpr int NB = 4, SEQ = 4096, DM = 1024, DEPTH = 4;
constexpr int M = NB * SEQ;
constexpr int ZP = 3328;
constexpr int NIN = 3144;
constexpr int DFF = 2816, PLE = 256;
constexpr float RMS_EPS = 1e-6f;
constexpr float LOG2E = 1.4426950408889634f;
constexpr float C2 = 0.125f * LOG2E;
constexpr int ZC_AIN = 0, ZC_AC = 256, ZC_AB = 512, ZC_PV = 768, ZC_Q = 1024  , ZC_K = 1536, ZC_V = 2048, ZC_IQ = 2560, ZC_IK = 3072, ZC_IW = 3136;

constexpr size_t MiB = 1u << 20;
constexpr size_t WS_CTL = 0, CTL_ZERO_BYTES = 64 * 1024;
constexpr size_t WS_RSSPX = 1 * MiB;
constexpr size_t WS_RSS1 = 2 * MiB;
constexpr size_t WS_RSSPT = 3 * MiB;
constexpr size_t WS_KM = 4 * MiB;
constexpr size_t WS_W = 8 * MiB;
constexpr size_t LW_WIN = 0, LW_WOUT = LW_WIN + (size_t)ZP * DM * 2, LW_WGU = LW_WOUT + (size_t)DM * DM * 2, LW_WD = LW_WGU + (size_t)2 * DFF * DM * 2,
                 LW_WG = LW_WD + (size_t)DM * DFF * 2, LW_WP = LW_WG + (size_t)DM * DM * 2, LW_BYTES = LW_WP + (size_t)DM * PLE * 2;
static_assert(LW_BYTES == 27 * MiB + MiB / 2, "per-layer weight block");
constexpr size_t WS_PB = WS_W + DEPTH * LW_BYTES;
constexpr size_t WS_XB = WS_PB + (size_t)DEPTH * M * PLE * 2;
constexpr size_t WS_RZ = WS_XB + (size_t)M * DM * 2;
constexpr size_t WS_RM = WS_RZ + (size_t)M * ZP * 2;
constexpr size_t WS_RV = WS_RM + (size_t)M * DM * 2;
constexpr size_t WS_VT = WS_RV, WS_DMASK = WS_RV + 16 * MiB;
constexpr size_t WS_END = WS_RV + 32 * MiB;
static_assert(WS_END == 350 * MiB, "workspace map");

constexpr int RING_BYTES = 131072;
constexpr int IDX_MROW_OFF = 131072;
constexpr int MISC_OFF = 143360;
constexpr int LDS_BYTES = 147456;
constexpr int NWAVES = 8, NTHREADS = 512;

#define LAS __attribute__((address_space(3)))
typedef unsigned short bf16;
typedef unsigned v4u __attribute__((ext_vector_type(4)));
typedef unsigned v2u __attribute__((ext_vector_type(2)));
typedef float f32x4 __attribute__((ext_vector_type(4)));
typedef float f32x16 __attribute__((ext_vector_type(16)));
typedef short bf16x8 __attribute__((ext_vector_type(8)));
typedef short s16x4 __attribute__((ext_vector_type(4)));
typedef unsigned long long u64;
#define LDS_WAIT() asm volatile("s_waitcnt lgkmcnt(0)" ::: "memory")
#define VM_WAIT() asm volatile("s_waitcnt vmcnt(0)" ::: "memory")
__device__ __forceinline__ unsigned f2bf(float f) { unsigned u = __builtin_bit_cast(unsigned, f); return (u + 0x7fffu + ((u >> 16) & 1u)) >> 16; }
__device__ __forceinline__ unsigned pk2(float lo, float hi) { return f2bf(lo) | (f2bf(hi) << 16); }
__device__ __forceinline__ float bflo(unsigned w) { return __builtin_bit_cast(float, w << 16); }
__device__ __forceinline__ float bfhi(unsigned w) { return __builtin_bit_cast(float, w & 0xffff0000u); }
__device__ __forceinline__ float bf1(bf16 v) { return __builtin_bit_cast(float, (unsigned)v << 16); }
__device__ __forceinline__ float wave_sum(float v) {
#pragma unroll
    for (int o = 1; o < 64; o <<= 1) v += __shfl_xor(v, o);
    return v;
}
__device__ __forceinline__ unsigned wave_sum_u(unsigned v) {
#pragma unroll
    for (int o = 1; o < 64; o <<= 1) v += (unsigned)__shfl_xor((int)v, o);
    return v;
}
__device__ __forceinline__ float sigmoidf_(float v) { return __builtin_amdgcn_rcpf(1.0f + __builtin_amdgcn_exp2f(-v * LOG2E)); }
#define XB_TMO      128
#define XB_XCNT(j)  (256  + 64 * (j))
#define XB_XSUB(j)  (1280 + 64 * (j))
#define XB_XGEN(j)  (2304 + 64 * (j))
#define XB_TOP      3328
#define XB_TOPGEN   3392
#define XCD_BAR_WORDS 3456
#define XB_SPIN_CAP (1u << 18)

__device__ __forceinline__ unsigned xb_ld(unsigned* p)              { return __hip_atomic_load(p, __ATOMIC_RELAXED, __HIP_MEMORY_SCOPE_AGENT); }
__device__ __forceinline__ unsigned xb_add(unsigned* p, unsigned v) { return __hip_atomic_fetch_add(p, v, __ATOMIC_RELAXED, __HIP_MEMORY_SCOPE_AGENT); }
__device__ __forceinline__ unsigned xb_xcc_id() { return (unsigned)__builtin_amdgcn_s_getreg((3 << 11) | 20) & 0xFu; }
#define XB_SPIN(cond, bar) do { unsigned _sp = 0; while (cond) { __builtin_amdgcn_s_sleep(1); \
    if ((++_sp & 255u) == 0u) { if (xb_ld(&(bar)[XB_TMO])) break; if (_sp > XB_SPIN_CAP) { atomicAdd(&(bar)[XB_TMO], 1u); break; } } } } while (0)

struct XcdBarrier {
    unsigned* bar; unsigned x;
    volatile LAS unsigned* st;
};

__device__ __forceinline__ XcdBarrier xcd_barrier_post(unsigned* bar, volatile LAS unsigned* st) {
    XcdBarrier b; b.bar = bar; b.x = xb_xcc_id(); b.st = st;
    if (threadIdx.x == 0) (void)xb_add(&bar[XB_XCNT(b.x)], 1u);
    return b;
}
__device__ __forceinline__ void xcd_barrier_complete(unsigned* bar, unsigned x, unsigned& nloc, unsigned& nx) {
    const unsigned G = gridDim.x * gridDim.y * gridDim.z;
    unsigned sum, cnt, mine, sp = 0u;
    for (;;) {
        sum = 0u; cnt = 0u; mine = 0u;
#pragma unroll
        for (unsigned j = 0; j < 16; ++j) { const unsigned c = xb_ld(&bar[XB_XCNT(j)]); sum += c; cnt += (c > 0u) ? 1u : 0u; mine = (j == x) ? c : mine; }
        if (sum == G) break;
        __builtin_amdgcn_s_sleep(1);
        if ((++sp & 255u) == 0u) { if (xb_ld(&bar[XB_TMO])) break; if (sp > XB_SPIN_CAP) { atomicAdd(&bar[XB_TMO], 1u); break; } }
    }
    nloc = mine > 0u ? mine : 1u; nx = cnt > 0u ? cnt : 1u;
}

__device__ __forceinline__ void xcd_barrier(const XcdBarrier& b) {
    asm volatile("s_waitcnt vmcnt(0)" ::: "memory");
    __syncthreads();
    if (threadIdx.x == 0) {
        unsigned* bar = b.bar;
        __builtin_amdgcn_s_waitcnt(0);
        unsigned nloc = b.st[0], nx = b.st[1];
        if (nloc == 0u) { xcd_barrier_complete(bar, b.x, nloc, nx); b.st[0] = nloc; b.st[1] = nx; }
        const unsigned old = xb_add(&bar[XB_XSUB(b.x)], 1u);
        const unsigned gen = old / nloc;
        if (old + 1u == (gen + 1u) * nloc) {
            __builtin_amdgcn_fence(__ATOMIC_RELEASE, "agent");
            asm volatile("s_waitcnt vmcnt(0)" ::: "memory");
            const unsigned og = xb_add(&bar[XB_TOP], 1u);
            const unsigned tg = og / nx;
            if (og + 1u == (tg + 1u) * nx) xb_add(&bar[XB_TOPGEN], 1u);
            else XB_SPIN(xb_ld(&bar[XB_TOPGEN]) == tg, bar);
            __builtin_amdgcn_fence(__ATOMIC_ACQUIRE, "agent");
            xb_add(&bar[XB_XGEN(b.x)], 1u);
            asm volatile("s_waitcnt vmcnt(0)" ::: "memory");
        } else {
            XB_SPIN(xb_ld(&bar[XB_XGEN(b.x)]) == gen, bar);
            __builtin_amdgcn_fence(__ATOMIC_ACQUIRE, "agent");
            asm volatile("s_waitcnt vmcnt(0)" ::: "memory");
        }
    }
    __syncthreads();
}

struct Args { const float* in[17]; float* out; unsigned char* ws; int ph_lo, ph_hi; };
struct Frame {
    LAS unsigned char* lds;
    int tid, lane, wave, vcu, G, bx;
    const float* const* in;
    float* X; unsigned char* ws;
};
#define IN_X 0
#define IN_P 1
#define IN_RELB 2
#define IN_GMIXPRE 3
#define IN_WIN 4
#define IN_CONVW 5
#define IN_POOLW 6
#define IN_POOLS 7
#define IN_WOUT 8
#define IN_GMIXPOST 9
#define IN_GFFNPRE 10
#define IN_WGU 11
#define IN_WDOWN 12
#define IN_GFFNPOST 13
#define IN_GPLE 14
#define IN_WPLEG 15
#define IN_WPLEP 16

typedef pg8::f32x4 (&AccRef)[2][2][4][2];
typedef const pg8::f32x4 (&AccCRef)[2][2][4][2];
__device__ __forceinline__ float dot4(f32x4 a) { return (a[0] * a[0] + a[1] * a[1]) + (a[2] * a[2] + a[3] * a[3]); }

struct EpiZ {
    static constexpr bool PERM = true, AFTER_DRAIN = false;
    bf16* Z; const float* rssp;
    __device__ __forceinline__ void operator()(AccCRef acc, const pg8::Unit& u, int wr, int wc, int fr, int fq) const {
        const int row0 = u.pm * 256 + wr * 64 + fr, col0 = u.pn * 256 + wc * 32 + 8 * fq;
#pragma unroll
        for (int ai = 0; ai < 2; ++ai)
#pragma unroll
            for (int m = 0; m < 4; ++m) {
                const int row = row0 + ai * 128 + m * 16;
                const f32x4* rp = (const f32x4*)(rssp + (size_t)row * 16);
                const f32x4 a = rp[0], b = rp[1], c = rp[2], d = rp[3];
                const float ss = ((a[0] + a[1]) + (a[2] + a[3])) + ((b[0] + b[1]) + (b[2] + b[3])) + ((c[0] + c[1]) + (c[2] + c[3])) + ((d[0] + d[1]) + (d[2] + d[3]));
                const float rs = rsqrtf(ss * (1.0f / DM) + RMS_EPS);
                bf16* rowp = Z + (size_t)row * ZP + col0;
#pragma unroll
                for (int bj = 0; bj < 2; ++bj) {
                    const f32x4 v0 = acc[ai][bj][m][0] * rs, v1 = acc[ai][bj][m][1] * rs;
                    v4u w; w.x = pk2(v0[0], v0[1]); w.y = pk2(v0[2], v0[3]); w.z = pk2(v1[0], v1[1]); w.w = pk2(v1[2], v1[3]);
                    *(v4u*)(rowp + bj * 128) = w;
                }
            }
    }
};
struct EpiT {
    static constexpr bool PERM = true, AFTER_DRAIN = false;
    bf16* T; float* rssp;
    __device__ __forceinline__ void operator()(AccCRef acc, const pg8::Unit& u, int wr, int wc, int fr, int fq) const {
        const int row0 = u.pm * 256 + wr * 64 + fr, col0 = u.pn * 256 + wc * 32 + 8 * fq;
#pragma unroll
        for (int ai = 0; ai < 2; ++ai)
#pragma unroll
            for (int m = 0; m < 4; ++m) {
                const int row = row0 + ai * 128 + m * 16;
                bf16* rowp = T + (size_t)row * DM + col0;
                float ss = 0.f;
#pragma unroll
                for (int bj = 0; bj < 2; ++bj) {
                    const f32x4 v0 = acc[ai][bj][m][0], v1 = acc[ai][bj][m][1];
                    ss += dot4(v0) + dot4(v1);
                    v4u w; w.x = pk2(v0[0], v0[1]); w.y = pk2(v0[2], v0[3]); w.z = pk2(v1[0], v1[1]); w.w = pk2(v1[2], v1[3]);
                    *(v4u*)(rowp + bj * 128) = w;
                }
                ss += __shfl_xor(ss, 16); ss += __shfl_xor(ss, 32);
                if (fq == 0) rssp[(size_t)row * 16 + u.pn * 4 + wc] = ss;
            }
    }
};
struct EpiB {
    static constexpr bool PERM = true, AFTER_DRAIN = false;
    bf16* T;
    __device__ __forceinline__ void operator()(AccCRef acc, const pg8::Unit& u, int wr, int wc, int fr, int fq) const {
        const int row0 = u.pm * 256 + wr * 64 + fr, col0 = u.pn * 256 + wc * 32 + 8 * fq;
#pragma unroll
        for (int ai = 0; ai < 2; ++ai)
#pragma unroll
            for (int m = 0; m < 4; ++m) {
                bf16* rowp = T + (size_t)(row0 + ai * 128 + m * 16) * DM + col0;
#pragma unroll
                for (int bj = 0; bj < 2; ++bj) {
                    const f32x4 v0 = acc[ai][bj][m][0], v1 = acc[ai][bj][m][1];
                    v4u w; w.x = pk2(v0[0], v0[1]); w.y = pk2(v0[2], v0[3]); w.z = pk2(v1[0], v1[1]); w.w = pk2(v1[2], v1[3]);
                    *(v4u*)(rowp + bj * 128) = w;
                }
            }
    }
};
struct EpiSwiGLU {
    static constexpr bool PERM = true, AFTER_DRAIN = false;
    bf16* H; const float* rss1;
    __device__ __forceinline__ void operator()(AccCRef acc, const pg8::Unit& u, int wr, int wc, int fr, int fq) const {
        const int row0 = u.pm * 256 + wr * 64 + fr, col0 = u.pn * 128 + wc * 32 + 8 * fq;
#pragma unroll
        for (int ai = 0; ai < 2; ++ai)
#pragma unroll
            for (int m = 0; m < 4; ++m) {
                const int row = row0 + ai * 128 + m * 16;
                const float rs = rsqrtf(rss1[row] * (1.0f / DM) + RMS_EPS);
                float h[8];
#pragma unroll
                for (int n = 0; n < 2; ++n)
#pragma unroll
                    for (int j = 0; j < 4; ++j) { const float g = acc[ai][0][m][n][j] * rs, up = acc[ai][1][m][n][j] * rs; h[n * 4 + j] = g * up * sigmoidf_(g); }
                v4u w; w.x = pk2(h[0], h[1]); w.y = pk2(h[2], h[3]); w.z = pk2(h[4], h[5]); w.w = pk2(h[6], h[7]);
                *(v4u*)(H + (size_t)row * DFF + col0) = w;
            }
    }
};
struct EpiPLE {
    static constexpr bool PERM = false, AFTER_DRAIN = false;
    float* X; bf16* XB; const bf16* T2; const float* rss1; float* rssp;
    __device__ __forceinline__ void operator()(AccCRef acc, const pg8::Unit& u, int wr, int wc, int fr, int fq) const {
        const int row0 = u.pm * 256 + wr * 64 + fr, col0 = u.pn * 256 + wc * 32 + 4 * fq;
#pragma unroll
        for (int ai = 0; ai < 2; ++ai)
#pragma unroll
            for (int m = 0; m < 4; ++m) {
                const int row = row0 + ai * 128 + m * 16;
                const float rs = rsqrtf(rss1[row] * (1.0f / DM) + RMS_EPS);
                float ss = 0.f;
#pragma unroll
                for (int bj = 0; bj < 2; ++bj)
#pragma unroll
                    for (int n = 0; n < 2; ++n) {
                        const size_t off = (size_t)row * DM + col0 + bj * 128 + n * 16;
                        const f32x4 xo = *(const f32x4*)(X + off); const v2u t2 = *(const v2u*)(T2 + off);
                        const f32x4 a = acc[ai][bj][m][n] * rs;
                        f32x4 xn;
                        xn[0] = xo[0] + sigmoidf_(a[0]) * bflo(t2.x); xn[1] = xo[1] + sigmoidf_(a[1]) * bfhi(t2.x);
                        xn[2] = xo[2] + sigmoidf_(a[2]) * bflo(t2.y); xn[3] = xo[3] + sigmoidf_(a[3]) * bfhi(t2.y);
                        ss += dot4(xn);
                        *(f32x4*)(X + off) = xn;
                        v2u w; w.x = pk2(xn[0], xn[1]); w.y = pk2(xn[2], xn[3]); *(v2u*)(XB + off) = w;
                    }
                ss += __shfl_xor(ss, 16); ss += __shfl_xor(ss, 32);
                if (fq == 0) rssp[(size_t)row * 16 + u.pn * 4 + wc] = ss;
            }
    }
};

__device__ __forceinline__ int win_src(int n) {
    if (n < 1280) return n;
    if (n < 1536) return 2376 + (n - 1280);
    if (n < 1792) return 1280 + (n - 1536);
    if (n < 2048) return 2632 + (n - 1792);
    if (n < 2304) return 1536 + (n - 2048);
    if (n < 2560) return 2888 + (n - 2304);
    if (n < 3072) return 1792 + (n - 2560);
    if (n < 3136) return 2304 + (n - 3072);
    if (n < 3144) return 2368 + (n - 3136);
    return -1;
}
template <int MAP>
__device__ __forceinline__ void tr_item(const float* W, int K, int Nsrc, int Ndst, const float* g, bf16* WT, LAS float* scr, int item, int lane) {
    const int nblk = Ndst / 32, kb = item / nblk, nb = item % nblk, k0 = 64 * kb, n0 = 32 * nb;
    const int nd = n0 + (lane & 31);
    int ns; float cs = 1.0f;
    if (MAP == 0) ns = nd;
    else if (MAP == 1) { ns = win_src(nd); if (nd >= ZC_Q && nd < ZC_K) cs = C2; }
    else { const int pn = nd >> 8, r = nd & 255; ns = (r < 128) ? (pn * 128 + r) : (DFF + pn * 128 + (r - 128)); }
#pragma unroll 8
    for (int i = 0; i < 32; ++i) {
        const int kk = 2 * i + (lane >> 5);
        float v = 0.f;
        if (ns >= 0) v = W[(size_t)(k0 + kk) * Nsrc + ns] * cs;
        if (g) v *= g[k0 + kk];
        scr[kk * 33 + (lane & 31)] = v;
    }
    LDS_WAIT(); asm volatile("" ::: "memory");
    const int c = lane & 7;
#pragma unroll
    for (int j = 0; j < 4; ++j) {
        const int n = (lane >> 3) + 8 * j; const LAS float* s = scr + (8 * c) * 33 + n;
        v4u o; o.x = pk2(s[0 * 33], s[1 * 33]); o.y = pk2(s[2 * 33], s[3 * 33]); o.z = pk2(s[4 * 33], s[5 * 33]); o.w = pk2(s[6 * 33], s[7 * 33]);
        *(v4u*)(WT + (size_t)(n0 + n) * K + k0 + 8 * c) = o;
    }
    LDS_WAIT(); asm volatile("" ::: "memory");
}
__device__ __forceinline__ void phase_prologue(const Frame& F) {
    LAS float* scr = (LAS float*)(F.lds + F.wave * 16384);
    const int gw = F.vcu * NWAVES + F.wave, NGW = F.G * NWAVES, lane = F.lane;
    constexpr int I_WIN = (DM / 64) * (ZP / 32), I_WOUT = (DM / 64) * (DM / 32), I_WGU = (DM / 64) * (2 * DFF / 32), I_WD = (DFF / 64) * (DM / 32), I_WG = I_WOUT, I_WP = (PLE / 64) * (DM / 32);
    constexpr int I_LAYER = I_WIN + I_WOUT + I_WGU + I_WD + I_WG + I_WP;
    for (int it = gw; it < DEPTH * I_LAYER; it += NGW) {
        const int L = it / I_LAYER; int r = it % I_LAYER;
        unsigned char* wl = F.ws + WS_W + (size_t)L * LW_BYTES;
        if (r < I_WIN) { tr_item<1>(F.in[IN_WIN] + (size_t)L * DM * NIN, DM, NIN, ZP, F.in[IN_GMIXPRE] + L * DM, (bf16*)(wl + LW_WIN), scr, r, lane); continue; } r -= I_WIN;
        if (r < I_WOUT) { tr_item<0>(F.in[IN_WOUT] + (size_t)L * DM * DM, DM, DM, DM, nullptr, (bf16*)(wl + LW_WOUT), scr, r, lane); continue; } r -= I_WOUT;
        if (r < I_WGU) { tr_item<2>(F.in[IN_WGU] + (size_t)L * DM * 2 * DFF, DM, 2 * DFF, 2 * DFF, F.in[IN_GFFNPRE] + L * DM, (bf16*)(wl + LW_WGU), scr, r, lane); continue; } r -= I_WGU;
        if (r < I_WD) { tr_item<0>(F.in[IN_WDOWN] + (size_t)L * DFF * DM, DFF, DM, DM, nullptr, (bf16*)(wl + LW_WD), scr, r, lane); continue; } r -= I_WD;
        if (r < I_WG) { tr_item<0>(F.in[IN_WPLEG] + (size_t)L * DM * DM, DM, DM, DM, F.in[IN_GPLE] + L * DM, (bf16*)(wl + LW_WG), scr, r, lane); continue; } r -= I_WG;
        tr_item<0>(F.in[IN_WPLEP] + (size_t)L * PLE * DM, PLE, DM, DM, nullptr, (bf16*)(wl + LW_WP), scr, r, lane);
    }
    {
        const f32x4* src = (const f32x4*)F.in[IN_P]; v2u* dst = (v2u*)(F.ws + WS_PB);
        const size_t n4 = (size_t)DEPTH * M * PLE / 4;
        for (size_t i = (size_t)F.vcu * NTHREADS + F.tid; i < n4; i += (size_t)F.G * NTHREADS) { const f32x4 v = src[i]; v2u w; w.x = pk2(v[0], v[1]); w.y = pk2(v[2], v[3]); dst[i] = w; }
    }
    {
        const float* x = F.in[IN_X]; bf16* XB = (bf16*)(F.ws + WS_XB); float* rssp = (float*)(F.ws + WS_RSSPX);
        for (int row = gw; row < M; row += NGW) {
            const f32x4* xr = (const f32x4*)(x + (size_t)row * DM) + lane; f32x4* xo = (f32x4*)(F.X + (size_t)row * DM) + lane; v2u* xb = (v2u*)(XB + (size_t)row * DM) + lane;
            float ss = 0.f;
#pragma unroll
            for (int j = 0; j < 4; ++j) { const f32x4 v = xr[64 * j]; ss += dot4(v); xo[64 * j] = v; v2u w; w.x = pk2(v[0], v[1]); w.y = pk2(v[2], v[3]); xb[64 * j] = w; }
            ss = wave_sum(ss);
            if (lane < 16) rssp[(size_t)row * 16 + lane] = (lane == 0) ? ss : 0.f;
        }
    }
}

__device__ __forceinline__ void phase_resid(const Frame& F, const bf16* T, const float* rsspt, const float* g) {
    const int gw = F.vcu * NWAVES + F.wave, NGW = F.G * NWAVES, lane = F.lane;
    bf16* XB = (bf16*)(F.ws + WS_XB); float* rss1 = (float*)(F.ws + WS_RSS1);
    f32x4 gv[4];
#pragma unroll
    for (int j = 0; j < 4; ++j) gv[j] = ((const f32x4*)g)[lane + 64 * j];
    for (int row = gw; row < M; row += NGW) {
        const f32x4* rp = (const f32x4*)(rsspt + (size_t)row * 16);
        const f32x4 a = rp[0], b = rp[1], c = rp[2], d = rp[3];
        const float st = ((a[0] + a[1]) + (a[2] + a[3])) + ((b[0] + b[1]) + (b[2] + b[3])) + ((c[0] + c[1]) + (c[2] + c[3])) + ((d[0] + d[1]) + (d[2] + d[3]));
        const float rs = rsqrtf(st * (1.0f / DM) + RMS_EPS);
        f32x4* xr = (f32x4*)(F.X + (size_t)row * DM) + lane; const v2u* tr = (const v2u*)(T + (size_t)row * DM) + lane; v2u* xb = (v2u*)(XB + (size_t)row * DM) + lane;
        float ss = 0.f;
#pragma unroll
        for (int j = 0; j < 4; ++j) {
            f32x4 v = xr[64 * j]; const v2u t = tr[64 * j];
            v[0] += gv[j][0] * bflo(t.x) * rs; v[1] += gv[j][1] * bfhi(t.x) * rs; v[2] += gv[j][2] * bflo(t.y) * rs; v[3] += gv[j][3] * bfhi(t.y) * rs;
            ss += dot4(v); xr[64 * j] = v; v2u w; w.x = pk2(v[0], v[1]); w.y = pk2(v[2], v[3]); xb[64 * j] = w;
        }
        ss = wave_sum(ss);
        if (lane == 0) rss1[row] = ss;
    }
}

__device__ __forceinline__ void phase_prep(const Frame& F, int L) {
    const bf16* Z = (const bf16*)(F.ws + WS_RZ); bf16* MIX = (bf16*)(F.ws + WS_RM);
    const int tid = F.tid, lane = F.lane, wave = F.wave;
    {
        const float* cw = F.in[IN_CONVW] + (size_t)L * 3 * 256;
        for (size_t i = (size_t)F.vcu * NTHREADS + tid; i < (size_t)M * 32; i += (size_t)F.G * NTHREADS) {
            const int row = (int)(i >> 5), c0 = (int)(i & 31) * 8, t = row & (SEQ - 1);
            float accv[8];
#pragma unroll
            for (int e = 0; e < 8; ++e) accv[e] = 0.f;
#pragma unroll
            for (int j = 0; j < 3; ++j) {
                const int tt = t - 2 + j;
                if (tt >= 0) {
                    const bf16* zr = Z + (size_t)(row - 2 + j) * ZP;
                    const v4u ain = *(const v4u*)(zr + ZC_AIN + c0), ac = *(const v4u*)(zr + ZC_AC + c0);
                    const f32x4 w0 = *(const f32x4*)(cw + j * 256 + c0), w1 = *(const f32x4*)(cw + j * 256 + c0 + 4);
                    accv[0] += w0[0] * bflo(ain.x) * bflo(ac.x); accv[1] += w0[1] * bfhi(ain.x) * bfhi(ac.x);
                    accv[2] += w0[2] * bflo(ain.y) * bflo(ac.y); accv[3] += w0[3] * bfhi(ain.y) * bfhi(ac.y);
                    accv[4] += w1[0] * bflo(ain.z) * bflo(ac.z); accv[5] += w1[1] * bfhi(ain.z) * bfhi(ac.z);
                    accv[6] += w1[2] * bflo(ain.w) * bflo(ac.w); accv[7] += w1[3] * bfhi(ain.w) * bfhi(ac.w);
                }
            }
            const v4u ab = *(const v4u*)(Z + (size_t)row * ZP + ZC_AB + c0);
            v4u o; o.x = pk2(accv[0] * bflo(ab.x), accv[1] * bfhi(ab.x)); o.y = pk2(accv[2] * bflo(ab.y), accv[3] * bfhi(ab.y));
            o.z = pk2(accv[4] * bflo(ab.z), accv[5] * bfhi(ab.z)); o.w = pk2(accv[6] * bflo(ab.w), accv[7] * bfhi(ab.w));
            *(v4u*)(MIX + (size_t)row * DM + c0) = o;
        }
    }
    {
        LAS float* Vs = (LAS float*)F.lds; LAS float* Ds = (LAS float*)(F.lds + 49152);
        const float* pw = F.in[IN_POOLW] + (size_t)L * 4 * 64 * 64; const float* ps = F.in[IN_POOLS] + (size_t)L * 256;
        const int oc = tid & 255, og = oc >> 6, oo = oc & 63, th = tid >> 8;
        float wreg[64];
#pragma unroll
        for (int c = 0; c < 64; ++c) wreg[c] = pw[(og * 64 + c) * 64 + oo];
        const float psc = ps[oc];
        for (int tile = F.vcu; tile < M / 32; tile += F.G) {
            const int row0 = tile * 32, t0 = row0 & (SEQ - 1);
            __syncthreads();
            for (int i = tid; i < 48 * 32; i += NTHREADS) {
                const int r = i >> 5, c0 = (i & 31) * 8, tt = t0 - 16 + r;
                float v[8];
                if (tt >= 0) { const v4u z = *(const v4u*)(Z + (size_t)(row0 - 16 + r) * ZP + ZC_PV + c0);
                    v[0] = bflo(z.x); v[1] = bfhi(z.x); v[2] = bflo(z.y); v[3] = bfhi(z.y); v[4] = bflo(z.z); v[5] = bfhi(z.z); v[6] = bflo(z.w); v[7] = bfhi(z.w); }
                else {
#pragma unroll
                    for (int e = 0; e < 8; ++e) v[e] = 0.f; }
#pragma unroll
                for (int e = 0; e < 8; ++e) Vs[r * 256 + c0 + e] = v[e];
            }
            __syncthreads();
            {
                const int w = 2 << og;
                for (int tl = th * 16; tl < th * 16 + 16; ++tl) {
                    float s = 0.f;
                    for (int j = 0; j < w; ++j) s += Vs[(tl + 16 - j) * 256 + oc];
                    const int tg = t0 + tl; const int cnt = (tg + 1 < w) ? (tg + 1) : w;
                    Ds[tl * 256 + oc] = s / (float)cnt - Vs[(tl + 16) * 256 + oc];
                }
            }
            __syncthreads();
            for (int tl = th * 16; tl < th * 16 + 16; ++tl) {
                const LAS f32x4* dr = (const LAS f32x4*)(Ds + tl * 256 + og * 64);
                float a = 0.f;
#pragma unroll
                for (int c4 = 0; c4 < 16; ++c4) { const f32x4 d = dr[c4]; a += d[0] * wreg[4 * c4] + d[1] * wreg[4 * c4 + 1] + d[2] * wreg[4 * c4 + 2] + d[3] * wreg[4 * c4 + 3]; }
                MIX[(size_t)(row0 + tl) * DM + 256 + oc] = (bf16)f2bf(a * psc);
            }
        }
        __syncthreads();
    }
    {
        bf16* Vt = (bf16*)(F.ws + WS_VT);
        LAS bf16* tl = (LAS bf16*)(F.lds + wave * 16384);
        const int gw = F.vcu * NWAVES + wave, NGW = F.G * NWAVES;
        for (int it = gw; it < NB * 8 * (SEQ / 64); it += NGW) {
            const int st = it & 63, bh = it >> 6, b = bh >> 3, h = bh & 7;
            const bf16* src = Z + (size_t)(b * SEQ + st * 64 + lane) * ZP + ZC_V + h * 64;
#pragma unroll
            for (int c = 0; c < 8; ++c) { const v4u v = *(const v4u*)(src + c * 8);
                const unsigned ww[4] = {v.x, v.y, v.z, v.w};
#pragma unroll
                for (int e = 0; e < 4; ++e) { tl[(c * 8 + 2 * e) * 66 + lane] = (bf16)(ww[e] & 0xffffu); tl[(c * 8 + 2 * e + 1) * 66 + lane] = (bf16)(ww[e] >> 16); } }
            LDS_WAIT(); asm volatile("" ::: "memory");
            bf16* dst = Vt + ((size_t)bh * 64 + lane) * SEQ + st * 64;
#pragma unroll
            for (int c = 0; c < 8; ++c) { v4u o; const LAS unsigned* s = (const LAS unsigned*)(tl + lane * 66 + c * 8); o.x = s[0]; o.y = s[1]; o.z = s[2]; o.w = s[3]; *(v4u*)(dst + c * 8) = o; }
            LDS_WAIT(); asm volatile("" ::: "memory");
        }
    }
    {
        float* KM = (float*)(F.ws + WS_KM);
        LAS float* red = (LAS float*)(F.lds + 131072);
        for (int it = F.vcu; it < NB * 16; it += F.G) {
            const int col = tid & 255, half = tid >> 8;
            const bf16* src = Z + (size_t)(it * 256 + half * 128) * ZP + ZC_K + 256 + col;
            float s = 0.f;
            for (int r = 0; r < 128; ++r) s += bf1(src[(size_t)r * ZP]);
            __syncthreads();
            if (half == 1) red[col] = s;
            __syncthreads();
            if (half == 0) KM[(size_t)it * 256 + col] = (s + red[col]) * (1.0f / 256.0f);
        }
        __syncthreads();
    }
}

typedef unsigned short u16x2 __attribute__((ext_vector_type(2)));
__device__ __forceinline__ unsigned cnt_ge_word(unsigned w, u16x2 cm1) {
    const u16x2 x = __builtin_bit_cast(u16x2, w);
    u16x2 d = __builtin_elementwise_sub_sat(x, cm1);
    const u16x2 one = {1, 1};
    d = __builtin_elementwise_min(d, one);
    return __builtin_bit_cast(unsigned, d);
}
__device__ __forceinline__ unsigned count_ge(const LAS unsigned short* row, int nchunks, unsigned cand, int lane) {
    const unsigned short c1 = (unsigned short)(cand - 1u); const u16x2 cm1 = {c1, c1};
    unsigned acc = 0;
    for (int c = 0; c < nchunks; ++c) {
        const v4u v = *(const LAS v4u*)(row + c * 512 + lane * 8);
        acc += cnt_ge_word(v.x, cm1) + cnt_ge_word(v.y, cm1) + cnt_ge_word(v.z, cm1) + cnt_ge_word(v.w, cm1);
    }
    return wave_sum_u((acc & 0xffffu) + (acc >> 16));
}
__device__ __forceinline__ void idx_tile(const Frame& F, int b, int qt) {
    const bf16* Z = (const bf16*)(F.ws + WS_RZ); u64* DMK = (u64*)(F.ws + WS_DMASK);
    LAS unsigned short* keys = (LAS unsigned short*)F.lds; LAS unsigned char* mrow = (LAS unsigned char*)(F.lds + IDX_MROW_OFF);
    const int tid = F.tid, lane = F.lane, wave = F.wave, q0 = qt * 16;
    if (qt < 16) {
        for (int i = tid; i < 16 * 512; i += NTHREADS) { const int qi = i >> 9, bi = i & 511, q = q0 + qi, k0 = bi * 8;
            mrow[i] = (unsigned char)((k0 + 7 <= q) ? 0xFFu : ((k0 > q) ? 0u : ((1u << (q - k0 + 1)) - 1u))); }
    } else {
        const int nchunks = (q0 + 16 + 511) >> 9;
        const size_t rb = (size_t)b * SEQ;
        {
            const int fr = lane & 15, fq = lane >> 4;
            bf16x8 A[8][2];
            const bf16* qrow = Z + (rb + q0 + fr) * ZP + ZC_IQ + fq * 8;
#pragma unroll
            for (int h = 0; h < 8; ++h)
#pragma unroll
                for (int ks = 0; ks < 2; ++ks) A[h][ks] = *(const bf16x8*)(qrow + h * 64 + ks * 32);
            float iw[4][8];
#pragma unroll
            for (int i = 0; i < 4; ++i) { const v4u w = *(const v4u*)(Z + (rb + q0 + fq * 4 + i) * ZP + ZC_IW);
                iw[i][0] = bflo(w.x); iw[i][1] = bfhi(w.x); iw[i][2] = bflo(w.y); iw[i][3] = bfhi(w.y); iw[i][4] = bflo(w.z); iw[i][5] = bfhi(w.z); iw[i][6] = bflo(w.w); iw[i][7] = bfhi(w.w); }
            for (int kt = wave; kt < nchunks * 32; kt += NWAVES) {
                const int key = kt * 16 + fr;
                const bf16* krow = Z + (rb + key) * ZP + ZC_IK + fq * 8;
                const bf16x8 B0 = *(const bf16x8*)(krow), B1 = *(const bf16x8*)(krow + 32);
                float sc[4] = {0.f, 0.f, 0.f, 0.f};
#pragma unroll
                for (int h = 0; h < 8; ++h) {
                    pg8::f32x4 acc = {0.f, 0.f, 0.f, 0.f};
                    acc = __builtin_amdgcn_mfma_f32_16x16x32_bf16(A[h][0], B0, acc, 0, 0, 0);
                    acc = __builtin_amdgcn_mfma_f32_16x16x32_bf16(A[h][1], B1, acc, 0, 0, 0);
#pragma unroll
                    for (int i = 0; i < 4; ++i) sc[i] += iw[i][h] * fmaxf(acc[i], 0.f);
                }
#pragma unroll
                for (int i = 0; i < 4; ++i) {
                    const int qi = fq * 4 + i;
                    const _Float16 hv = (_Float16)sc[i];
                    const unsigned bits = (unsigned)__builtin_bit_cast(unsigned short, hv);
                    unsigned mono = (bits & 0x8000u) ? (~bits & 0xffffu) : (bits | 0x8000u);
                    if (key > q0 + qi) mono = 0u;
                    keys[qi * 4096 + key] = (unsigned short)mono;
                }
            }
        }
        __syncthreads();
        for (int qq = 0; qq < 2; ++qq) {
            const int qi = wave + 8 * qq;
            const LAS unsigned short* row = keys + qi * 4096;
            unsigned T = 0;
            for (int bit = 15; bit >= 0; --bit) { const unsigned cand = T | (1u << bit); if (count_ge(row, nchunks, cand, lane) >= 256u) T = cand; }
            const unsigned cnt_gt = (T == 0xffffu) ? 0u : count_ge(row, nchunks, T + 1u, lane);
            const unsigned need_eq = 256u - cnt_gt;
            unsigned base = 0;
            LAS unsigned char* mr = mrow + qi * 512;
            for (int c = 0; c < nchunks; ++c) {
                const v4u v = *(const LAS v4u*)(row + c * 512 + lane * 8);
                const unsigned ww[4] = {v.x, v.y, v.z, v.w};
                unsigned gtb = 0, eqb = 0;
#pragma unroll
                for (int e = 0; e < 4; ++e) { const unsigned lo = ww[e] & 0xffffu, hi = ww[e] >> 16;
                    gtb |= (lo > T ? 1u : 0u) << (2 * e); gtb |= (hi > T ? 1u : 0u) << (2 * e + 1);
                    eqb |= (lo == T ? 1u : 0u) << (2 * e); eqb |= (hi == T ? 1u : 0u) << (2 * e + 1); }
                const unsigned e = (unsigned)__builtin_popcount(eqb);
                unsigned incl = e;
#pragma unroll
                for (int o = 1; o < 64; o <<= 1) { const unsigned t = (unsigned)__shfl_up((int)incl, o); if (lane >= o) incl += t; }
                unsigned rank = base + incl - e, sel = gtb;
#pragma unroll
                for (int j = 0; j < 8; ++j) { if ((eqb >> j) & 1u) { if (rank < need_eq) sel |= 1u << j; ++rank; } }
                mr[c * 64 + lane] = (unsigned char)sel;
                base += (unsigned)__shfl((int)incl, 63);
            }
            for (int i = nchunks * 64 + lane; i < 512; i += 64) mr[i] = 0;
        }
    }
    __syncthreads();
    for (int i = tid; i < 1024; i += NTHREADS) { const int t64 = i >> 4, qi = i & 15;
        const LAS unsigned* s = (const LAS unsigned*)(mrow + qi * 512 + t64 * 8);
        DMK[((size_t)(b * 64 + t64)) * SEQ + q0 + qi] = (u64)s[0] | ((u64)s[1] << 32); }
    __syncthreads();
}
__device__ __forceinline__ void phase_index(const Frame& F) {
    for (int pi = F.vcu; pi < 512; pi += F.G) { const int b = pi >> 7, s = pi & 127; idx_tile(F, b, s); idx_tile(F, b, 255 - s); }
}

__device__ __forceinline__ int crow(int r, int hi) { return (r & 3) + 8 * (r >> 2) + 4 * hi; }
__device__ __forceinline__ unsigned cvtpk(float lo, float hi) { typedef float f2 __attribute__((ext_vector_type(2))); typedef __bf16 b2 __attribute__((ext_vector_type(2)));
    f2 v = {lo, hi}; b2 b = __builtin_convertvector(v, b2); return __builtin_bit_cast(unsigned, b); }
#define MFMA32(a, b, c) __builtin_amdgcn_mfma_f32_32x32x16_bf16((a), (b), (c), 0, 0, 0)
__device__ __forceinline__ void attn_unit(const Frame& F, int b, int h8, int qb) {
    const bf16* Z = (const bf16*)(F.ws + WS_RZ); const bf16* Vt = (const bf16*)(F.ws + WS_VT); const u64* DMK = (const u64*)(F.ws + WS_DMASK);
    const float* KM = (const float*)(F.ws + WS_KM); bf16* MIX = (bf16*)(F.ws + WS_RM);
    LAS unsigned char* lds = F.lds; const LAS float* biasT = (const LAS float*)(F.lds + 32768) + h8 * 128;
    const int tid = F.tid, lane = F.lane, w = F.wave, r32 = lane & 31, hi = lane >> 5;
    const bool moba = h8 >= 4;
    const int q0 = qb * 256, qw0 = q0 + w * 32, q = qw0 + r32;
    const size_t rb = (size_t)b * SEQ;
    bf16x8 qf[4];
    { const bf16* Qp = Z + (rb + q) * ZP + ZC_Q + h8 * 64 + 8 * hi;
#pragma unroll
      for (int d0 = 0; d0 < 4; ++d0) qf[d0] = *(const bf16x8*)(Qp + 16 * d0); }
    unsigned selmask = 0;
    if (moba && qb > 0) {
        float qv[64];
        { const bf16* Qr = Z + (rb + q) * ZP + ZC_Q + h8 * 64;
#pragma unroll
          for (int c = 0; c < 8; ++c) { const v4u v = *(const v4u*)(Qr + c * 8);
              qv[c * 8 + 0] = bflo(v.x); qv[c * 8 + 1] = bfhi(v.x); qv[c * 8 + 2] = bflo(v.y); qv[c * 8 + 3] = bfhi(v.y); qv[c * 8 + 4] = bflo(v.z); qv[c * 8 + 5] = bfhi(v.z); qv[c * 8 + 6] = bflo(v.w); qv[c * 8 + 7] = bfhi(v.w); } }
        float g0 = -INFINITY, g1 = -INFINITY, g2 = -INFINITY; int i0 = -1, i1 = -1, i2 = -1;
        for (int n = 0; n < qb; ++n) {
            const float* km = KM + ((size_t)(b * 16 + n) * 4 + (h8 - 4)) * 64;
            float g = 0.f;
#pragma unroll
            for (int d = 0; d < 64; ++d) g += qv[d] * km[d];
            if (g > g0) { g2 = g1; i2 = i1; g1 = g0; i1 = i0; g0 = g; i0 = n; }
            else if (g > g1) { g2 = g1; i2 = i1; g1 = g; i1 = n; }
            else if (g > g2) { g2 = g; i2 = n; }
        }
        if (i0 >= 0) selmask |= 1u << i0; if (i1 >= 0) selmask |= 1u << i1; if (i2 >= 0) selmask |= 1u << i2;
    }
    f32x16 o0, o1;
#pragma unroll
    for (int r = 0; r < 16; ++r) { o0[r] = 0.f; o1[r] = 0.f; }
    float mrun = 0.f, lrun = 0.f;
    const float biasfar = biasT[127];
    const int ntiles = 4 * (qb + 1);
    const int lrow = tid >> 3, lch = tid & 7;
    const bf16* Kg = Z + (rb + lrow) * ZP + ZC_K + h8 * 64 + lch * 8;
    const bf16* Vg = Vt + ((size_t)(b * 8 + h8) * 64 + lrow) * SEQ + lch * 8;
    const int st_off = lrow * 128 + ((lch ^ (lrow & 7)) << 4);
    v4u kreg = *(const v4u*)Kg, vreg = *(const v4u*)Vg;
    for (int t = 0; t < ntiles; ++t) {
        const int buf = (t & 1) * 8192;
        *(LAS v4u*)(lds + buf + st_off) = kreg; *(LAS v4u*)(lds + 16384 + buf + st_off) = vreg;
        __syncthreads();
        if (t + 1 < ntiles) { kreg = *(const v4u*)(Kg + (size_t)(t + 1) * 64 * ZP); vreg = *(const v4u*)(Vg + (t + 1) * 64); }
        if (64 * t > qw0 + 31) continue;
        u64 word;
        if (!moba) word = DMK[((size_t)(b * 64 + t)) * SEQ + q];
        else { const int blk = t >> 2;
            if (blk == qb) { const int rel = q - 64 * t; word = (rel >= 63) ? ~0ull : ((rel < 0) ? 0ull : ((2ull << rel) - 1ull)); }
            else word = ((selmask >> blk) & 1u) ? ~0ull : 0ull; }
        if (__all(word == 0ull)) continue;
        const bool nearT = (qw0 - (64 * t + 63)) < 113;
        const float cinit = nearT ? 0.f : biasfar;
        f32x16 p0, p1;
#pragma unroll
        for (int r = 0; r < 16; ++r) { p0[r] = cinit; p1[r] = cinit; }
        { const LAS unsigned char* Kb = lds + buf + r32 * 128;
#pragma unroll
          for (int d0 = 0; d0 < 4; ++d0) {
              const int ch = ((2 * d0 + hi) ^ (r32 & 7)) << 4;
              const bf16x8 ka = *(const LAS bf16x8*)(Kb + ch), kb2 = *(const LAS bf16x8*)(Kb + 4096 + ch);
              p0 = MFMA32(ka, qf[d0], p0); p1 = MFMA32(kb2, qf[d0], p1); } }
        const unsigned wlo = (unsigned)word, whi = (unsigned)(word >> 32);
        if (nearT) {
            const int dbase = q - 64 * t;
#pragma unroll
            for (int r = 0; r < 16; ++r) { const int d0_ = dbase - crow(r, hi), d1_ = d0_ - 32;
                p0[r] += biasT[d0_ < 0 ? 0 : (d0_ > 127 ? 127 : d0_)]; p1[r] += biasT[d1_ < 0 ? 0 : (d1_ > 127 ? 127 : d1_)]; }
        }
#pragma unroll
        for (int r = 0; r < 16; ++r) { const int kv = crow(r, hi);
            if (!((wlo >> kv) & 1u)) p0[r] = -INFINITY; if (!((whi >> kv) & 1u)) p1[r] = -INFINITY; }
        float mx = fmaxf(p0[0], p1[0]);
#pragma unroll
        for (int r = 1; r < 16; ++r) mx = fmaxf(mx, fmaxf(p0[r], p1[r]));
        mx = fmaxf(mx, __shfl_xor(mx, 32));
        const float mnew = fmaxf(mrun, mx), alpha = __builtin_amdgcn_exp2f(mrun - mnew);
        mrun = mnew;
        float ls = 0.f;
#pragma unroll
        for (int r = 0; r < 16; ++r) { p0[r] = __builtin_amdgcn_exp2f(p0[r] - mnew); p1[r] = __builtin_amdgcn_exp2f(p1[r] - mnew); ls += p0[r] + p1[r]; o0[r] *= alpha; o1[r] *= alpha; }
        lrun = lrun * alpha + ls;
        bf16x8 pf[4];
        { v4u a; a.x = cvtpk(p0[0], p0[1]); a.y = cvtpk(p0[2], p0[3]); a.z = cvtpk(p0[4], p0[5]); a.w = cvtpk(p0[6], p0[7]); pf[0] = __builtin_bit_cast(bf16x8, a);
          a.x = cvtpk(p0[8], p0[9]); a.y = cvtpk(p0[10], p0[11]); a.z = cvtpk(p0[12], p0[13]); a.w = cvtpk(p0[14], p0[15]); pf[1] = __builtin_bit_cast(bf16x8, a);
          a.x = cvtpk(p1[0], p1[1]); a.y = cvtpk(p1[2], p1[3]); a.z = cvtpk(p1[4], p1[5]); a.w = cvtpk(p1[6], p1[7]); pf[2] = __builtin_bit_cast(bf16x8, a);
          a.x = cvtpk(p1[8], p1[9]); a.y = cvtpk(p1[10], p1[11]); a.z = cvtpk(p1[12], p1[13]); a.w = cvtpk(p1[14], p1[15]); pf[3] = __builtin_bit_cast(bf16x8, a); }
        { const LAS unsigned char* Vb = lds + 16384 + buf + r32 * 128 + 8 * hi;
#pragma unroll
          for (int ks = 0; ks < 4; ++ks) {
              const int c0 = 2 * ks;
              const int ca = ((c0 ^ (r32 & 7)) << 4), cb = (((c0 + 1) ^ (r32 & 7)) << 4);
              const s16x4 a0 = *(const LAS s16x4*)(Vb + ca), a1 = *(const LAS s16x4*)(Vb + cb);
              const s16x4 b0 = *(const LAS s16x4*)(Vb + 4096 + ca), b1 = *(const LAS s16x4*)(Vb + 4096 + cb);
              const bf16x8 va = __builtin_shufflevector(a0, a1, 0, 1, 2, 3, 4, 5, 6, 7), vb = __builtin_shufflevector(b0, b1, 0, 1, 2, 3, 4, 5, 6, 7);
              o0 = MFMA32(va, pf[ks], o0); o1 = MFMA32(vb, pf[ks], o1); } }
    }
    lrun += __shfl_xor(lrun, 32);
    const float rl = 1.0f / lrun;
    bf16* orow = MIX + (rb + q) * DM + 512 + h8 * 64 + 4 * hi;
#pragma unroll
    for (int g = 0; g < 4; ++g) {
        v2u a; a.x = pk2(o0[4 * g] * rl, o0[4 * g + 1] * rl); a.y = pk2(o0[4 * g + 2] * rl, o0[4 * g + 3] * rl); *(v2u*)(orow + 8 * g) = a;
        v2u c; c.x = pk2(o1[4 * g] * rl, o1[4 * g + 1] * rl); c.y = pk2(o1[4 * g + 2] * rl, o1[4 * g + 3] * rl); *(v2u*)(orow + 32 + 8 * g) = c;
    }
    __syncthreads();
}
__device__ __forceinline__ void phase_attn(const Frame& F) {
    { LAS float* bt = (LAS float*)(F.lds + 32768); const float* rbias = F.in[IN_RELB];
      const int th[16] = {16, 19, 21, 24, 27, 31, 35, 40, 46, 52, 59, 67, 77, 87, 99, 113};
      for (int i = F.tid; i < 8 * 128; i += NTHREADS) { const int h = i >> 7, d = i & 127; int bk = d;
          if (d >= 16) { bk = 15;
#pragma unroll
              for (int k = 0; k < 16; ++k) bk += (d >= th[k]) ? 1 : 0; }
          bt[i] = rbias[h * 32 + bk] * LOG2E; }
      __syncthreads(); }
    for (int pi = F.vcu; pi < 256; pi += F.G) { const int bh = pi >> 3, s = pi & 7; attn_unit(F, bh >> 3, bh & 7, s); attn_unit(F, bh >> 3, bh & 7, 15 - s); }
}

constexpr int NPHASES = 1 + 9 * DEPTH;
#ifndef PH_MASK
#define PH_MASK 0x3ff
#endif
#define PHM(k) ((PH_MASK >> (k)) & 1)
#ifndef MK_ONE_LAUNCH
#define MK_ONE_LAUNCH 1
#endif
__device__ __forceinline__ Frame relaunder(const Frame& F0) {
    Frame F = F0; int t; asm volatile("v_mbcnt_lo_u32_b32 %0, -1, 0\n\tv_mbcnt_hi_u32_b32 %0, -1, %0\n\tv_lshl_add_u32 %0, %1, 6, %0" : "=&v"(t) : "s"(F0.wave)); F.tid = t; F.lane = t & 63; F.wave = __builtin_amdgcn_readfirstlane(t >> 6);
    asm volatile("" : "+s"(F.ws)); asm volatile("" : "+s"(F.X)); asm volatile("" : "+s"(F.G)); asm volatile("" : "+s"(F.vcu)); asm volatile("" : "+s"(F.bx));
    return F; }
__global__ void __launch_bounds__(NTHREADS, 2) fwd(Args args) {
    extern __shared__ __attribute__((aligned(16))) unsigned char lds_raw[];
    Frame F;
    F.lds = (LAS unsigned char*)lds_raw;
    F.tid = threadIdx.x; F.lane = F.tid & 63; F.wave = __builtin_amdgcn_readfirstlane(F.tid >> 6);
    F.G = gridDim.x; F.bx = blockIdx.x; { const int bx = blockIdx.x; F.vcu = (F.G % 8 == 0) ? (bx % 8) * (F.G / 8) + bx / 8 : bx; }
    F.in = args.in; F.X = args.out; F.ws = args.ws;
    if (F.tid < 4) ((LAS unsigned*)(F.lds + MISC_OFF))[F.tid] = 0u;
    __syncthreads();
    const int lo = args.ph_lo, hi = args.ph_hi;
    if (hi - lo > 1) (void)xcd_barrier_post((unsigned*)(args.ws + WS_CTL), (volatile LAS unsigned*)(F.lds + MISC_OFF));
#define IN(k) (lo <= (k) && (k) < hi)
#define SEAM(k) do { if (IN(k) && IN((k) + 1)) { unsigned char* wsb = args.ws; asm volatile("" : "+s"(wsb)); XcdBarrier b_; b_.bar = (unsigned*)(wsb + WS_CTL); b_.x = xb_xcc_id(); b_.st = (volatile LAS unsigned*)(F.lds + MISC_OFF); xcd_barrier(b_); } } while (0)
    unsigned char* const ws = args.ws;
    if (PHM(0) && IN(0)) { const Frame Fl = relaunder(F); phase_prologue(Fl); }
    SEAM(0);

    { constexpr int L = 0;
    {
        const int p0 = 1 + 9 * L;
        unsigned char* wl = ws + WS_W + (size_t)L * LW_BYTES;
        if (PHM(1) && IN(p0 + 0)) {
            const Frame Fl = relaunder(F); unsigned char* const wsl = Fl.ws; unsigned char* const wll = wsl + WS_W + (size_t)L * LW_BYTES; pg8::Gemm g{(const bf16*)(wsl + WS_XB), (const bf16*)(wll + LW_WIN), M, ZP, DM}; pg8::StaticOrder S; S.init(M, ZP, Fl.G, Fl.bx);
            EpiZ E{(bf16*)(wsl + WS_RZ), (const float*)(wsl + WS_RSSPX)};
            pg8::gemm_phase<EpiZ, pg8::StaticOrder, true, true>(F.lds, g, S, E, Fl.tid);
        }
        SEAM(p0 + 0);
        if (PHM(2) && IN(p0 + 1)) { { const Frame Fl = relaunder(F); phase_index(Fl); } { const Frame Fl = relaunder(F); phase_prep(Fl, L); } }
        SEAM(p0 + 1);
        if (PHM(3) && IN(p0 + 2)) { const Frame Fl = relaunder(F); phase_attn(Fl); }
        SEAM(p0 + 2);
        if (PHM(4) && IN(p0 + 3)) {
            const Frame Fl = relaunder(F); unsigned char* const wsl = Fl.ws; unsigned char* const wll = wsl + WS_W + (size_t)L * LW_BYTES; pg8::Gemm g{(const bf16*)(wsl + WS_RM), (const bf16*)(wll + LW_WOUT), M, DM, DM}; pg8::StaticOrder S; S.init(M, DM, Fl.G, Fl.bx);
            EpiT E{(bf16*)(wsl + WS_RZ), (float*)(wsl + WS_RSSPT)};
            pg8::gemm_phase<EpiT, pg8::StaticOrder, true, true>(F.lds, g, S, E, Fl.tid);
        }
        SEAM(p0 + 3);
        if (PHM(5) && IN(p0 + 4)) { const Frame Fl = relaunder(F); phase_resid(Fl, (const bf16*)(Fl.ws + WS_RZ), (const float*)(Fl.ws + WS_RSSPT), Fl.in[IN_GMIXPOST] + L * DM); }
        SEAM(p0 + 4);
        if (PHM(6) && IN(p0 + 5)) {
            const Frame Fl = relaunder(F); unsigned char* const wsl = Fl.ws; unsigned char* const wll = wsl + WS_W + (size_t)L * LW_BYTES; pg8::Gemm g{(const bf16*)(wsl + WS_XB), (const bf16*)(wll + LW_WGU), M, 2 * DFF, DM}; pg8::StaticOrder S; S.init(M, 2 * DFF, Fl.G, Fl.bx);
            EpiSwiGLU E{(bf16*)(wsl + WS_RZ), (const float*)(wsl + WS_RSS1)};
            pg8::gemm_phase<EpiSwiGLU, pg8::StaticOrder, true, true>(F.lds, g, S, E, Fl.tid);
        }
        SEAM(p0 + 5);
        if (PHM(7) && IN(p0 + 6)) {
            { const Frame Fl = relaunder(F); unsigned char* const wsl = Fl.ws; unsigned char* const wll = wsl + WS_W + (size_t)L * LW_BYTES; pg8::Gemm g{(const bf16*)(wsl + WS_RZ), (const bf16*)(wll + LW_WD), M, DM, DFF}; pg8::StaticOrder S; S.init(M, DM, Fl.G, Fl.bx);
              EpiT E{(bf16*)(wsl + WS_RM), (float*)(wsl + WS_RSSPT)};
              pg8::gemm_phase<EpiT, pg8::StaticOrder, true, true>(F.lds, g, S, E, Fl.tid); }
            __syncthreads();
            { const Frame Fl = relaunder(F); unsigned char* const wsl = Fl.ws; unsigned char* const wll = wsl + WS_W + (size_t)L * LW_BYTES; pg8::Gemm g{(const bf16*)(wsl + WS_PB) + (size_t)L * M * PLE, (const bf16*)(wll + LW_WP), M, DM, PLE}; pg8::StaticOrder S; S.init(M, DM, Fl.G, Fl.bx);
              EpiB E{(bf16*)(wsl + WS_RV)};
              pg8::gemm_phase<EpiB, pg8::StaticOrder, true, true>(F.lds, g, S, E, Fl.tid); }
        }
        SEAM(p0 + 6);
        if (PHM(8) && IN(p0 + 7)) { const Frame Fl = relaunder(F); phase_resid(Fl, (const bf16*)(Fl.ws + WS_RM), (const float*)(Fl.ws + WS_RSSPT), Fl.in[IN_GFFNPOST] + L * DM); }
        SEAM(p0 + 7);
        if (PHM(9) && IN(p0 + 8)) {
            const Frame Fl = relaunder(F); unsigned char* const wsl = Fl.ws; unsigned char* const wll = wsl + WS_W + (size_t)L * LW_BYTES; pg8::Gemm g{(const bf16*)(wsl + WS_XB), (const bf16*)(wll + LW_WG), M, DM, DM}; pg8::StaticOrder S; S.init(M, DM, Fl.G, Fl.bx);
            EpiPLE E{Fl.X, (bf16*)(wsl + WS_XB), (const bf16*)(wsl + WS_RV), (const float*)(wsl + WS_RSS1), (float*)(wsl + WS_RSSPX)};
            pg8::gemm_phase<EpiPLE, pg8::StaticOrder, true, true>(F.lds, g, S, E, Fl.tid);
        }
        SEAM(p0 + 8);
    }
        }

    { constexpr int L = 1;
    {
        const int p0 = 1 + 9 * L;
        unsigned char* wl = ws + WS_W + (size_t)L * LW_BYTES;
        if (PHM(1) && IN(p0 + 0)) {
            const Frame Fl = relaunder(F); unsigned char* const wsl = Fl.ws; unsigned char* const wll = wsl + WS_W + (size_t)L * LW_BYTES; pg8::Gemm g{(const bf16*)(wsl + WS_XB), (const bf16*)(wll + LW_WIN), M, ZP, DM}; pg8::StaticOrder S; S.init(M, ZP, Fl.G, Fl.bx);
            EpiZ E{(bf16*)(wsl + WS_RZ), (const float*)(wsl + WS_RSSPX)};
            pg8::gemm_phase<EpiZ, pg8::StaticOrder, true, true>(F.lds, g, S, E, Fl.tid);
        }
        SEAM(p0 + 0);
        if (PHM(2) && IN(p0 + 1)) { { const Frame Fl = relaunder(F); phase_index(Fl); } { const Frame Fl = relaunder(F); phase_prep(Fl, L); } }
        SEAM(p0 + 1);
        if (PHM(3) && IN(p0 + 2)) { const Frame Fl = relaunder(F); phase_attn(Fl); }
        SEAM(p0 + 2);
        if (PHM(4) && IN(p0 + 3)) {
            const Frame Fl = relaunder(F); unsigned char* const wsl = Fl.ws; unsigned char* const wll = wsl + WS_W + (size_t)L * LW_BYTES; pg8::Gemm g{(const bf16*)(wsl + WS_RM), (const bf16*)(wll + LW_WOUT), M, DM, DM}; pg8::StaticOrder S; S.init(M, DM, Fl.G, Fl.bx);
            EpiT E{(bf16*)(wsl + WS_RZ), (float*)(wsl + WS_RSSPT)};
            pg8::gemm_phase<EpiT, pg8::StaticOrder, true, true>(F.lds, g, S, E, Fl.tid);
        }
        SEAM(p0 + 3);
        if (PHM(5) && IN(p0 + 4)) { const Frame Fl = relaunder(F); phase_resid(Fl, (const bf16*)(Fl.ws + WS_RZ), (const float*)(Fl.ws + WS_RSSPT), Fl.in[IN_GMIXPOST] + L * DM); }
        SEAM(p0 + 4);
        if (PHM(6) && IN(p0 + 5)) {
            const Frame Fl = relaunder(F); unsigned char* const wsl = Fl.ws; unsigned char* const wll = wsl + WS_W + (size_t)L * LW_BYTES; pg8::Gemm g{(const bf16*)(wsl + WS_XB), (const bf16*)(wll + LW_WGU), M, 2 * DFF, DM}; pg8::StaticOrder S; S.init(M, 2 * DFF, Fl.G, Fl.bx);
            EpiSwiGLU E{(bf16*)(wsl + WS_RZ), (const float*)(wsl + WS_RSS1)};
            pg8::gemm_phase<EpiSwiGLU, pg8::StaticOrder, true, true>(F.lds, g, S, E, Fl.tid);
        }
        SEAM(p0 + 5);
        if (PHM(7) && IN(p0 + 6)) {
            { const Frame Fl = relaunder(F); unsigned char* const wsl = Fl.ws; unsigned char* const wll = wsl + WS_W + (size_t)L * LW_BYTES; pg8::Gemm g{(const bf16*)(wsl + WS_RZ), (const bf16*)(wll + LW_WD), M, DM, DFF}; pg8::StaticOrder S; S.init(M, DM, Fl.G, Fl.bx);
              EpiT E{(bf16*)(wsl + WS_RM), (float*)(wsl + WS_RSSPT)};
              pg8::gemm_phase<EpiT, pg8::StaticOrder, true, true>(F.lds, g, S, E, Fl.tid); }
            __syncthreads();
            { const Frame Fl = relaunder(F); unsigned char* const wsl = Fl.ws; unsigned char* const wll = wsl + WS_W + (size_t)L * LW_BYTES; pg8::Gemm g{(const bf16*)(wsl + WS_PB) + (size_t)L * M * PLE, (const bf16*)(wll + LW_WP), M, DM, PLE}; pg8::StaticOrder S; S.init(M, DM, Fl.G, Fl.bx);
              EpiB E{(bf16*)(wsl + WS_RV)};
              pg8::gemm_phase<EpiB, pg8::StaticOrder, true, true>(F.lds, g, S, E, Fl.tid); }
        }
        SEAM(p0 + 6);
        if (PHM(8) && IN(p0 + 7)) { const Frame Fl = relaunder(F); phase_resid(Fl, (const bf16*)(Fl.ws + WS_RM), (const float*)(Fl.ws + WS_RSSPT), Fl.in[IN_GFFNPOST] + L * DM); }
        SEAM(p0 + 7);
        if (PHM(9) && IN(p0 + 8)) {
            const Frame Fl = relaunder(F); unsigned char* const wsl = Fl.ws; unsigned char* const wll = wsl + WS_W + (size_t)L * LW_BYTES; pg8::Gemm g{(const bf16*)(wsl + WS_XB), (const bf16*)(wll + LW_WG), M, DM, DM}; pg8::StaticOrder S; S.init(M, DM, Fl.G, Fl.bx);
            EpiPLE E{Fl.X, (bf16*)(wsl + WS_XB), (const bf16*)(wsl + WS_RV), (const float*)(wsl + WS_RSS1), (float*)(wsl + WS_RSSPX)};
            pg8::gemm_phase<EpiPLE, pg8::StaticOrder, true, true>(F.lds, g, S, E, Fl.tid);
        }
        SEAM(p0 + 8);
    }
        }

    { constexpr int L = 2;
    {
        const int p0 = 1 + 9 * L;
        unsigned char* wl = ws + WS_W + (size_t)L * LW_BYTES;
        if (PHM(1) && IN(p0 + 0)) {
            const Frame Fl = relaunder(F); unsigned char* const wsl = Fl.ws; unsigned char* const wll = wsl + WS_W + (size_t)L * LW_BYTES; pg8::Gemm g{(const bf16*)(wsl + WS_XB), (const bf16*)(wll + LW_WIN), M, ZP, DM}; pg8::StaticOrder S; S.init(M, ZP, Fl.G, Fl.bx);
            EpiZ E{(bf16*)(wsl + WS_RZ), (const float*)(wsl + WS_RSSPX)};
            pg8::gemm_phase<EpiZ, pg8::StaticOrder, true, true>(F.lds, g, S, E, Fl.tid);
        }
        SEAM(p0 + 0);
        if (PHM(2) && IN(p0 + 1)) { { const Frame Fl = relaunder(F); phase_index(Fl); } { const Frame Fl = relaunder(F); phase_prep(Fl, L); } }
        SEAM(p0 + 1);
        if (PHM(3) && IN(p0 + 2)) { const Frame Fl = relaunder(F); phase_attn(Fl); }
        SEAM(p0 + 2);
        if (PHM(4) && IN(p0 + 3)) {
            const Frame Fl = relaunder(F); unsigned char* const wsl = Fl.ws; unsigned char* const wll = wsl + WS_W + (size_t)L * LW_BYTES; pg8::Gemm g{(const bf16*)(wsl + WS_RM), (const bf16*)(wll + LW_WOUT), M, DM, DM}; pg8::StaticOrder S; S.init(M, DM, Fl.G, Fl.bx);
            EpiT E{(bf16*)(wsl + WS_RZ), (float*)(wsl + WS_RSSPT)};
            pg8::gemm_phase<EpiT, pg8::StaticOrder, true, true>(F.lds, g, S, E, Fl.tid);
        }
        SEAM(p0 + 3);
        if (PHM(5) && IN(p0 + 4)) { const Frame Fl = relaunder(F); phase_resid(Fl, (const bf16*)(Fl.ws + WS_RZ), (const float*)(Fl.ws + WS_RSSPT), Fl.in[IN_GMIXPOST] + L * DM); }
        SEAM(p0 + 4);
        if (PHM(6) && IN(p0 + 5)) {
            const Frame Fl = relaunder(F); unsigned char* const wsl = Fl.ws; unsigned char* const wll = wsl + WS_W + (size_t)L * LW_BYTES; pg8::Gemm g{(const bf16*)(wsl + WS_XB), (const bf16*)(wll + LW_WGU), M, 2 * DFF, DM}; pg8::StaticOrder S; S.init(M, 2 * DFF, Fl.G, Fl.bx);
            EpiSwiGLU E{(bf16*)(wsl + WS_RZ), (const float*)(wsl + WS_RSS1)};
            pg8::gemm_phase<EpiSwiGLU, pg8::StaticOrder, true, true>(F.lds, g, S, E, Fl.tid);
        }
        SEAM(p0 + 5);
        if (PHM(7) && IN(p0 + 6)) {
            { const Frame Fl = relaunder(F); unsigned char* const wsl = Fl.ws; unsigned char* const wll = wsl + WS_W + (size_t)L * LW_BYTES; pg8::Gemm g{(const bf16*)(wsl + WS_RZ), (const bf16*)(wll + LW_WD), M, DM, DFF}; pg8::StaticOrder S; S.init(M, DM, Fl.G, Fl.bx);
              EpiT E{(bf16*)(wsl + WS_RM), (float*)(wsl + WS_RSSPT)};
              pg8::gemm_phase<EpiT, pg8::StaticOrder, true, true>(F.lds, g, S, E, Fl.tid); }
            __syncthreads();
            { const Frame Fl = relaunder(F); unsigned char* const wsl = Fl.ws; unsigned char* const wll = wsl + WS_W + (size_t)L * LW_BYTES; pg8::Gemm g{(const bf16*)(wsl + WS_PB) + (size_t)L * M * PLE, (const bf16*)(wll + LW_WP), M, DM, PLE}; pg8::StaticOrder S; S.init(M, DM, Fl.G, Fl.bx);
              EpiB E{(bf16*)(wsl + WS_RV)};
              pg8::gemm_phase<EpiB, pg8::StaticOrder, true, true>(F.lds, g, S, E, Fl.tid); }
        }
        SEAM(p0 + 6);
        if (PHM(8) && IN(p0 + 7)) { const Frame Fl = relaunder(F); phase_resid(Fl, (const bf16*)(Fl.ws + WS_RM), (const float*)(Fl.ws + WS_RSSPT), Fl.in[IN_GFFNPOST] + L * DM); }
        SEAM(p0 + 7);
        if (PHM(9) && IN(p0 + 8)) {
            const Frame Fl = relaunder(F); unsigned char* const wsl = Fl.ws; unsigned char* const wll = wsl + WS_W + (size_t)L * LW_BYTES; pg8::Gemm g{(const bf16*)(wsl + WS_XB), (const bf16*)(wll + LW_WG), M, DM, DM}; pg8::StaticOrder S; S.init(M, DM, Fl.G, Fl.bx);
            EpiPLE E{Fl.X, (bf16*)(wsl + WS_XB), (const bf16*)(wsl + WS_RV), (const float*)(wsl + WS_RSS1), (float*)(wsl + WS_RSSPX)};
            pg8::gemm_phase<EpiPLE, pg8::StaticOrder, true, true>(F.lds, g, S, E, Fl.tid);
        }
        SEAM(p0 + 8);
    }
        }

    { constexpr int L = 3;
    {
        const int p0 = 1 + 9 * L;
        unsigned char* wl = ws + WS_W + (size_t)L * LW_BYTES;
        if (PHM(1) && IN(p0 + 0)) {
            const Frame Fl = relaunder(F); unsigned char* const wsl = Fl.ws; unsigned char* const wll = wsl + WS_W + (size_t)L * LW_BYTES; pg8::Gemm g{(const bf16*)(wsl + WS_XB), (const bf16*)(wll + LW_WIN), M, ZP, DM}; pg8::StaticOrder S; S.init(M, ZP, Fl.G, Fl.bx);
            EpiZ E{(bf16*)(wsl + WS_RZ), (const float*)(wsl + WS_RSSPX)};
            pg8::gemm_phase<EpiZ, pg8::StaticOrder, true, true>(F.lds, g, S, E, Fl.tid);
        }
        SEAM(p0 + 0);
        if (PHM(2) && IN(p0 + 1)) { { const Frame Fl = relaunder(F); phase_index(Fl); } { const Frame Fl = relaunder(F); phase_prep(Fl, L); } }
        SEAM(p0 + 1);
        if (PHM(3) && IN(p0 + 2)) { const Frame Fl = relaunder(F); phase_attn(Fl); }
        SEAM(p0 + 2);
        if (PHM(4) && IN(p0 + 3)) {
            const Frame Fl = relaunder(F); unsigned char* const wsl = Fl.ws; unsigned char* const wll = wsl + WS_W + (size_t)L * LW_BYTES; pg8::Gemm g{(const bf16*)(wsl + WS_RM), (const bf16*)(wll + LW_WOUT), M, DM, DM}; pg8::StaticOrder S; S.init(M, DM, Fl.G, Fl.bx);
            EpiT E{(bf16*)(wsl + WS_RZ), (float*)(wsl + WS_RSSPT)};
            pg8::gemm_phase<EpiT, pg8::StaticOrder, true, true>(F.lds, g, S, E, Fl.tid);
        }
        SEAM(p0 + 3);
        if (PHM(5) && IN(p0 + 4)) { const Frame Fl = relaunder(F); phase_resid(Fl, (const bf16*)(Fl.ws + WS_RZ), (const float*)(Fl.ws + WS_RSSPT), Fl.in[IN_GMIXPOST] + L * DM); }
        SEAM(p0 + 4);
        if (PHM(6) && IN(p0 + 5)) {
            const Frame Fl = relaunder(F); unsigned char* const wsl = Fl.ws; unsigned char* const wll = wsl + WS_W + (size_t)L * LW_BYTES; pg8::Gemm g{(const bf16*)(wsl + WS_XB), (const bf16*)(wll + LW_WGU), M, 2 * DFF, DM}; pg8::StaticOrder S; S.init(M, 2 * DFF, Fl.G, Fl.bx);
            EpiSwiGLU E{(bf16*)(wsl + WS_RZ), (const float*)(wsl + WS_RSS1)};
            pg8::gemm_phase<EpiSwiGLU, pg8::StaticOrder, true, true>(F.lds, g, S, E, Fl.tid);
        }
        SEAM(p0 + 5);
        if (PHM(7) && IN(p0 + 6)) {
            { const Frame Fl = relaunder(F); unsigned char* const wsl = Fl.ws; unsigned char* const wll = wsl + WS_W + (size_t)L * LW_BYTES; pg8::Gemm g{(const bf16*)(wsl + WS_RZ), (const bf16*)(wll + LW_WD), M, DM, DFF}; pg8::StaticOrder S; S.init(M, DM, Fl.G, Fl.bx);
              EpiT E{(bf16*)(wsl + WS_RM), (float*)(wsl + WS_RSSPT)};
              pg8::gemm_phase<EpiT, pg8::StaticOrder, true, true>(F.lds, g, S, E, Fl.tid); }
            __syncthreads();
            { const Frame Fl = relaunder(F); unsigned char* const wsl = Fl.ws; unsigned char* const wll = wsl + WS_W + (size_t)L * LW_BYTES; pg8::Gemm g{(const bf16*)(wsl + WS_PB) + (size_t)L * M * PLE, (const bf16*)(wll + LW_WP), M, DM, PLE}; pg8::StaticOrder S; S.init(M, DM, Fl.G, Fl.bx);
              EpiB E{(bf16*)(wsl + WS_RV)};
              pg8::gemm_phase<EpiB, pg8::StaticOrder, true, true>(F.lds, g, S, E, Fl.tid); }
        }
        SEAM(p0 + 6);
        if (PHM(8) && IN(p0 + 7)) { const Frame Fl = relaunder(F); phase_resid(Fl, (const bf16*)(Fl.ws + WS_RM), (const float*)(Fl.ws + WS_RSSPT), Fl.in[IN_GFFNPOST] + L * DM); }
        SEAM(p0 + 7);
        if (PHM(9) && IN(p0 + 8)) {
            const Frame Fl = relaunder(F); unsigned char* const wsl = Fl.ws; unsigned char* const wll = wsl + WS_W + (size_t)L * LW_BYTES; pg8::Gemm g{(const bf16*)(wsl + WS_XB), (const bf16*)(wll + LW_WG), M, DM, DM}; pg8::StaticOrder S; S.init(M, DM, Fl.G, Fl.bx);
            EpiPLE E{Fl.X, (bf16*)(wsl + WS_XB), (const bf16*)(wsl + WS_RV), (const float*)(wsl + WS_RSS1), (float*)(wsl + WS_RSSPX)};
            pg8::gemm_phase<EpiPLE, pg8::StaticOrder, true, true>(F.lds, g, S, E, Fl.tid);
        }
        SEAM(p0 + 8);
    }
        }

#undef IN
#undef SEAM
}

extern "C" void kernel_launch(void* const* d_in, const int* in_sizes, int n_in, void* d_out, int out_size, void* d_ws, size_t ws_size, hipStream_t stream) {
    static int grid = 0;
    if (grid == 0) {
        if (n_in != 17 || in_sizes[0] != M * DM || out_size != M * DM || ws_size < WS_END) {
            fprintf(stderr, "kernel_launch: unexpected problem (n_in %d, in0 %d, out %d, ws %zu < %zu); nothing launched\n", n_in, n_in > 0 ? in_sizes[0] : -1, out_size, ws_size, (size_t)WS_END); grid = -1; return; }
        int dev = 0, cus = 0, per_cu = 0;
        if (hipGetDevice(&dev) != hipSuccess || hipDeviceGetAttribute(&cus, hipDeviceAttributeMultiprocessorCount, dev) != hipSuccess) { grid = -1; return; }
        if (hipFuncSetAttribute((const void*)fwd, hipFuncAttributeMaxDynamicSharedMemorySize, LDS_BYTES) != hipSuccess) { fprintf(stderr, "kernel_launch: hipFuncSetAttribute failed\n"); grid = -1; return; }
        if (hipOccupancyMaxActiveBlocksPerMultiprocessor(&per_cu, (const void*)fwd, NTHREADS, LDS_BYTES) != hipSuccess || per_cu < 1)
            fprintf(stderr, "kernel_launch: occupancy query reports %d workgroups per CU\n", per_cu);
        (void)hipGetLastError();
        grid = cus;
    }
    if (grid < 0) return;
    if (hipMemsetAsync((char*)d_ws + WS_CTL, 0, CTL_ZERO_BYTES, stream) != hipSuccess) return;
    Args a{};
    for (int i = 0; i < 17; ++i) a.in[i] = (const float*)d_in[i];
    a.out = (float*)d_out; a.ws = (unsigned char*)d_ws;
#if MK_ONE_LAUNCH
    a.ph_lo = 0; a.ph_hi = NPHASES;
    hipLaunchKernelGGL(fwd, dim3(grid), dim3(NTHREADS), LDS_BYTES, stream, a);
#else
    for (int p = 0; p < NPHASES; ++p) { a.ph_lo = p; a.ph_hi = p + 1; hipLaunchKernelGGL(fwd, dim3(grid), dim3(NTHREADS), LDS_BYTES, stream, a); }
#endif
}
```

```cpp
#include <hip/hip_runtime.h>
#include <cstdio>
#include <cstdint>
namespace pg8 {
#define PG8_LAS __attribute__((address_space(3)))
typedef unsigned short bf16_t;
typedef short bf16x8 __attribute__((ext_vector_type(8)));
typedef float f32x4 __attribute__((ext_vector_type(4)));
typedef unsigned u32x4 __attribute__((ext_vector_type(4)));
constexpr int BM = 256, BK = 64, HALF = 128, HTB = HALF * BK * 2  , STAGE_BYTES = 8 * HTB, NXCD = 8, WGM = 8;

__host__ __device__ __forceinline__ int lds_byte(int r, int c) { const int st = (r >> 4) * 2 + (c >> 5), rr = r & 15, cc = c & 31, ob = rr * 64 + cc * 2; return st * 1024 + (ob ^ (((ob >> 9) & 1) << 5)); }
__host__ __device__ __forceinline__ void stage_rc(int b, int& R, int& C) { const int st = b / 1024, sb = b % 1024, swz = sb ^ (((sb >> 9) & 1) << 5); R = (st >> 1) * 16 + swz / 64; C = (st & 1) * 32 + (swz % 64) / 2; }
__host__ __device__ __forceinline__ int perm32(int rho) { const int n = rho >> 4, i = rho & 15; return 8 * (i >> 2) + 4 * n + (i & 3); }

struct Unit { int pm, pn; };
struct Gemm { const bf16_t* A; const bf16_t* Bt; int M, N, K; };

struct StaticOrder {
    int nM, nN, nwg, G, c;
    __host__ __device__ void init(int M, int N, int G_, int c_) { nM = M / BM; nN = N / BM; nwg = nM * nN; G = G_; c = c_; }
    __host__ __device__ bool next(int i, Unit& u) const {
        const long L = (long)i * G + c; if (L >= nwg) return false;
        int wgid = (int)L; { const int q = nwg / NXCD, r = nwg % NXCD, xcd = wgid % NXCD, off = wgid / NXCD; wgid = (xcd < r ? xcd * (q + 1) : r * (q + 1) + (xcd - r) * q) + off; }
        const int nig = WGM * nN, gid = wgid / nig, fm = gid * WGM, gsz = (nM - fm) < WGM ? (nM - fm) : WGM;
        u.pm = fm + ((wgid % nig) % gsz); u.pn = (wgid % nig) / gsz; return true;
    }
    __device__ __forceinline__ void a_ready(const Unit&) const {}
    __device__ __forceinline__ void done(const Unit&) const {}
};

template <class Epi, class Sched, bool ALIGN_EPI = false, bool SP2 = false>
__device__ __forceinline__ void gemm_phase(PG8_LAS unsigned char* lds, const Gemm g, const Sched& S, const Epi& E, int tid_in) {
    int tid_l = tid_in; asm volatile("" : "+v"(tid_l)); const int tid = tid_l, wid = __builtin_amdgcn_readfirstlane(tid >> 6), lane = tid & 63, wr = wid >> 2, wc = wid & 3, fr = lane & 15, fq = lane >> 4;
    const int K = g.K, nt = K / BK;
    unsigned voffA[2], voffB[2];
#pragma unroll
    for (int i = 0; i < 2; ++i) { int R, C; stage_rc(tid * 16 + i * 8192, R, C); const int Rb = Epi::PERM ? ((R & ~31) + perm32(R & 31)) : R;
        voffA[i] = (unsigned)(R * K + C) * 2u; voffB[i] = (unsigned)(Rb * K + C) * 2u; }
    const size_t kstep = (size_t)(BK * 2);
    const size_t hstep = (size_t)HALF * K * 2;
    const size_t tstep = 2 * hstep;
    const unsigned ldsw = (unsigned)wid * 1024u;
    const int aoff = lds_byte(wr * 64 + fr, fq * 8), boff = lds_byte(wc * 32 + fr, fq * 8);
#define PG8_SA(b, h) (((b) * 2 + (h)) * HTB)
#define PG8_SB(b, h) ((4 + (b) * 2 + (h)) * HTB)
#define PG8_STAGE(bufoff, gbase, voff) do { _Pragma("unroll") for (int _i = 0; _i < 2; ++_i) \
        __builtin_amdgcn_global_load_lds((const unsigned*)((const char*)(gbase) + (voff)[_i]), (PG8_LAS unsigned*)(lds + (bufoff) + ldsw + _i * 8192), 16, 0, 0); } while (0)
#define PG8_LDA(dst, b, h) do { _Pragma("unroll") for (int m = 0; m < 4; ++m) _Pragma("unroll") for (int k = 0; k < 2; ++k) dst[m][k] = *(const PG8_LAS bf16x8*)(lds + PG8_SA(b, h) + aoff + m * 2048 + k * 1024); } while (0)
#define PG8_LDB(dst, b, h) do { _Pragma("unroll") for (int n = 0; n < 2; ++n) _Pragma("unroll") for (int k = 0; k < 2; ++k) dst[n][k] = *(const PG8_LAS bf16x8*)(lds + PG8_SB(b, h) + boff + n * 2048 + k * 1024); } while (0)
#define PG8_MMA(ai, bj, At, Bt) do { __builtin_amdgcn_s_setprio(1); _Pragma("unroll") for (int m = 0; m < 4; ++m) _Pragma("unroll") for (int n = 0; n < 2; ++n) _Pragma("unroll") for (int k = 0; k < 2; ++k) \
        acc[ai][bj][m][n] = __builtin_amdgcn_mfma_f32_16x16x32_bf16(Bt[n][k], At[m][k], acc[ai][bj][m][n], 0, 0, 0); __builtin_amdgcn_s_setprio(0); } while (0)
#define PG8_WAIT_V(n) asm volatile("s_waitcnt vmcnt(" #n ")" ::: "memory")
#define PG8_WAIT_L(n) asm volatile("s_waitcnt lgkmcnt(" #n ")" ::: "memory")
#define PG8_BAR __builtin_amdgcn_s_barrier()
#define PG8_SCHED __builtin_amdgcn_sched_barrier(0)
    Unit cur, nxt; int ui = 0;
    if (!S.next(0, cur)) return;
    f32x4 acc[2][2][4][2];
#pragma unroll
    for (int a = 0; a < 2; ++a)
#pragma unroll
        for (int b = 0; b < 2; ++b)
#pragma unroll
            for (int m = 0; m < 4; ++m)
#pragma unroll
                for (int n = 0; n < 2; ++n) acc[a][b][m][n] = (f32x4){0.f, 0.f, 0.f, 0.f};
    bf16x8 At[4][2], B0[2][2], B1[2][2];
    const char* cA = (const char*)g.A + (size_t)cur.pm * tstep; const char* cB = (const char*)g.Bt + (size_t)cur.pn * tstep;
    S.a_ready(cur);
    if constexpr (SP2) {
        PG8_STAGE(PG8_SB(0, 0), cB, voffB); PG8_STAGE(PG8_SB(0, 1), cB + hstep, voffB); PG8_STAGE(PG8_SA(0, 0), cA, voffA); PG8_STAGE(PG8_SA(0, 1), cA + hstep, voffA);
        if (wr == 1) PG8_BAR;
        PG8_WAIT_V(2); PG8_BAR;
        PG8_STAGE(PG8_SB(1, 0), cB + kstep, voffB); PG8_STAGE(PG8_SA(1, 0), cA + kstep, voffA); PG8_STAGE(PG8_SB(1, 1), cB + hstep + kstep, voffB);
        PG8_WAIT_V(6); PG8_BAR;
    } else {
        PG8_STAGE(PG8_SB(0, 0), cB, voffB); PG8_STAGE(PG8_SA(0, 0), cA, voffA); PG8_STAGE(PG8_SB(0, 1), cB + hstep, voffB); PG8_STAGE(PG8_SA(0, 1), cA + hstep, voffA);
        if (wr == 1) PG8_BAR;
        PG8_WAIT_V(4); PG8_BAR;
        PG8_STAGE(PG8_SB(1, 0), cB + kstep, voffB); PG8_STAGE(PG8_SA(1, 0), cA + kstep, voffA); PG8_STAGE(PG8_SB(1, 1), cB + hstep + kstep, voffB);
        PG8_WAIT_V(6); PG8_BAR;
    }
    for (;;) {
        const bool has_next = S.next(ui + 1, nxt);
        const char* nA = has_next ? (const char*)g.A + (size_t)nxt.pm * tstep : cA; const char* nB = has_next ? (const char*)g.Bt + (size_t)nxt.pn * tstep : cB;
        for (int t = 0; t < nt; t += 2) {
            const bool last = (t == nt - 2);
            const char* a1 = cA + (size_t)(t + 1) * kstep;
            const char* a2 = last ? nA : cA + (size_t)(t + 2) * kstep; const char* b2 = last ? nB : cB + (size_t)(t + 2) * kstep;
            const char* a3 = a2 + kstep; const char* b3 = b2 + kstep;
            if (last && has_next) S.a_ready(nxt);
            if constexpr (SP2) {
            PG8_LDB(B0, 0, 0); PG8_LDB(B1, 0, 1); PG8_SCHED; PG8_LDA(At, 0, 0); PG8_STAGE(PG8_SA(1, 1), a1 + hstep, voffA);
            PG8_WAIT_V(8); PG8_WAIT_L(0); PG8_BAR; PG8_MMA(0, 0, At, B0); PG8_MMA(0, 1, At, B1); PG8_BAR; PG8_SCHED;
            PG8_LDA(At, 0, 1); PG8_STAGE(PG8_SB(0, 0), b2, voffB); PG8_STAGE(PG8_SB(0, 1), b2 + hstep, voffB); PG8_STAGE(PG8_SA(0, 0), a2, voffA);
            PG8_WAIT_V(8); PG8_WAIT_L(0); PG8_BAR; PG8_MMA(1, 0, At, B0); PG8_MMA(1, 1, At, B1); PG8_BAR; PG8_SCHED;
            PG8_LDB(B0, 1, 0); PG8_LDB(B1, 1, 1); PG8_SCHED; PG8_LDA(At, 1, 0); PG8_STAGE(PG8_SA(0, 1), a2 + hstep, voffA);
            PG8_WAIT_V(8); PG8_WAIT_L(0); PG8_BAR; PG8_MMA(0, 0, At, B0); PG8_MMA(0, 1, At, B1); PG8_BAR; PG8_SCHED;
            PG8_LDA(At, 1, 1); PG8_STAGE(PG8_SB(1, 0), b3, voffB); PG8_STAGE(PG8_SB(1, 1), b3 + hstep, voffB); PG8_STAGE(PG8_SA(1, 0), a3, voffA);
            PG8_WAIT_V(8); PG8_WAIT_L(0); PG8_BAR; PG8_MMA(1, 0, At, B0); PG8_MMA(1, 1, At, B1); PG8_BAR; PG8_SCHED;
            } else {
            PG8_LDB(B0, 0, 0); PG8_SCHED; PG8_LDA(At, 0, 0); PG8_STAGE(PG8_SA(1, 1), a1 + hstep, voffA);
            PG8_WAIT_L(8); PG8_BAR; PG8_WAIT_L(0); PG8_MMA(0, 0, At, B0); PG8_BAR; PG8_SCHED;
            PG8_LDB(B1, 0, 1); PG8_STAGE(PG8_SB(0, 0), b2, voffB);
            PG8_BAR; PG8_WAIT_L(0); PG8_MMA(0, 1, At, B1); PG8_BAR;
            PG8_LDA(At, 0, 1); PG8_STAGE(PG8_SA(0, 0), a2, voffA);
            PG8_BAR; PG8_WAIT_L(0); PG8_MMA(1, 0, At, B0); PG8_BAR; PG8_SCHED;
            PG8_STAGE(PG8_SB(0, 1), b2 + hstep, voffB);
            PG8_WAIT_V(6); PG8_BAR; PG8_MMA(1, 1, At, B1); PG8_BAR;
            PG8_LDB(B0, 1, 0); PG8_SCHED; PG8_LDA(At, 1, 0); PG8_STAGE(PG8_SA(0, 1), a2 + hstep, voffA);
            PG8_WAIT_L(8); PG8_BAR; PG8_WAIT_L(0); PG8_MMA(0, 0, At, B0); PG8_BAR; PG8_SCHED;
            PG8_LDB(B1, 1, 1); PG8_STAGE(PG8_SB(1, 0), b3, voffB);
            PG8_BAR; PG8_WAIT_L(0); PG8_MMA(0, 1, At, B1); PG8_BAR;
            PG8_LDA(At, 1, 1); PG8_STAGE(PG8_SA(1, 0), a3, voffA);
            PG8_BAR; PG8_WAIT_L(0); PG8_MMA(1, 0, At, B0); PG8_BAR; PG8_SCHED;
            PG8_STAGE(PG8_SB(1, 1), b3 + hstep, voffB);
            PG8_WAIT_V(6); PG8_BAR; PG8_MMA(1, 1, At, B1); PG8_BAR;
            }
        }
        if constexpr (ALIGN_EPI) { if (wr == 0) PG8_BAR; }
        if constexpr (!Epi::AFTER_DRAIN) { E(acc, cur, wr, wc, fr, fq); S.done(cur); }
        if (!has_next) break;
#pragma unroll
        for (int a = 0; a < 2; ++a)
#pragma unroll
            for (int b = 0; b < 2; ++b)
#pragma unroll
                for (int m = 0; m < 4; ++m)
#pragma unroll
                    for (int n = 0; n < 2; ++n) acc[a][b][m][n] = (f32x4){0.f, 0.f, 0.f, 0.f};
        cur = nxt; cA = nA; cB = nB; ++ui;
        if constexpr (ALIGN_EPI) { if (wr == 1) PG8_BAR; }
    }
    PG8_WAIT_V(0);
    if constexpr (!ALIGN_EPI) { if (wr == 0) PG8_BAR; }
    PG8_BAR;
    if constexpr (Epi::AFTER_DRAIN) { E.fused(acc, cur, wr, wc, fr, fq, lds, wid, lane); S.done(cur); }
#undef PG8_SA
#undef PG8_SB
#undef PG8_STAGE
#undef PG8_LDA
#undef PG8_LDB
#undef PG8_MMA
#undef PG8_WAIT_V
#undef PG8_WAIT_L
#undef PG8_BAR
#undef PG8_SCHED
}
}

constexpr int NB = 4, SEQ = 4096, DM = 1024, DEPTH = 4;
constexpr int M = NB * SEQ;
constexpr int ZP = 3328;
constexpr int NIN = 3144;
constexpr int DFF = 2816, PLE = 256;
constexpr float RMS_EPS = 1e-6f;
constexpr float LOG2E = 1.4426950408889634f;
constexpr float C2 = 0.125f * LOG2E;
constexpr int ZC_AIN = 0, ZC_AC = 256, ZC_AB = 512, ZC_PV = 768, ZC_Q = 1024  , ZC_K = 1536, ZC_V = 2048, ZC_IQ = 2560, ZC_IK = 3072, ZC_IW = 3136;

constexpr size_t MiB = 1u << 20;
constexpr size_t WS_CTL = 0, CTL_ZERO_BYTES = 64 * 1024;
constexpr size_t WS_RSSPX = 1 * MiB;
constexpr size_t WS_RSS1 = 2 * MiB;
constexpr size_t WS_RSSPT = 3 * MiB;
constexpr size_t WS_KM = 4 * MiB;
constexpr size_t WS_W = 8 * MiB;
constexpr size_t LW_WIN = 0, LW_WOUT = LW_WIN + (size_t)ZP * DM * 2, LW_WGU = LW_WOUT + (size_t)DM * DM * 2, LW_WD = LW_WGU + (size_t)2 * DFF * DM * 2,
                 LW_WG = LW_WD + (size_t)DM * DFF * 2, LW_WP = LW_WG + (size_t)DM * DM * 2, LW_BYTES = LW_WP + (size_t)DM * PLE * 2;
static_assert(LW_BYTES == 27 * MiB + MiB / 2, "per-layer weight block");
constexpr size_t WS_PB = WS_W + DEPTH * LW_BYTES;
constexpr size_t WS_XB = WS_PB + (size_t)DEPTH * M * PLE * 2;
constexpr size_t WS_RZ = WS_XB + (size_t)M * DM * 2;
constexpr size_t WS_RM = WS_RZ + (size_t)M * ZP * 2;
constexpr size_t WS_RV = WS_RM + (size_t)M * DM * 2;
constexpr size_t WS_VT = WS_RV, WS_DMASK = WS_RV + 16 * MiB;
constexpr size_t WS_END = WS_RV + 32 * MiB;
static_assert(WS_END == 350 * MiB, "workspace map");

constexpr int RING_BYTES = 131072;
constexpr int IDX_MROW_OFF = 131072;
constexpr int MISC_OFF = 143360;
constexpr int LDS_BYTES = 147456;
constexpr int NWAVES = 8, NTHREADS = 512;

#define LAS __attribute__((address_space(3)))
#define GAS __attribute__((address_space(1)))
typedef unsigned short bf16;
typedef unsigned v4u __attribute__((ext_vector_type(4)));
typedef unsigned v2u __attribute__((ext_vector_type(2)));
typedef float f32x4 __attribute__((ext_vector_type(4)));
typedef float f32x16 __attribute__((ext_vector_type(16)));
typedef short bf16x8 __attribute__((ext_vector_type(8)));
typedef short s16x4 __attribute__((ext_vector_type(4)));
typedef unsigned long long u64;
#define LDS_WAIT() asm volatile("s_waitcnt lgkmcnt(0)" ::: "memory")
#define VM_WAIT() asm volatile("s_waitcnt vmcnt(0)" ::: "memory")
__device__ __forceinline__ unsigned f2bf(float f) { unsigned u = __builtin_bit_cast(unsigned, f); return (u + 0x7fffu + ((u >> 16) & 1u)) >> 16; }
__device__ __forceinline__ unsigned pk2(float lo, float hi) { return f2bf(lo) | (f2bf(hi) << 16); }
__device__ __forceinline__ float bflo(unsigned w) { return __builtin_bit_cast(float, w << 16); }
__device__ __forceinline__ float bfhi(unsigned w) { return __builtin_bit_cast(float, w & 0xffff0000u); }
__device__ __forceinline__ float bf1(bf16 v) { return __builtin_bit_cast(float, (unsigned)v << 16); }
__device__ __forceinline__ float wave_sum(float v) {
#pragma unroll
    for (int o = 1; o < 64; o <<= 1) v += __shfl_xor(v, o);
    return v;
}
__device__ __forceinline__ unsigned wave_sum_u(unsigned v) {
#pragma unroll
    for (int o = 1; o < 64; o <<= 1) v += (unsigned)__shfl_xor((int)v, o);
    return v;
}
__device__ __forceinline__ float sigmoidf_(float v) { return __builtin_amdgcn_rcpf(1.0f + __builtin_amdgcn_exp2f(-v * LOG2E)); }
#define XB_TMO      128
#define XB_XCNT(j)  (256  + 64 * (j))
#define XB_XSUB(j)  (1280 + 64 * (j))
#define XB_XGEN(j)  (2304 + 64 * (j))
#define XB_TOP      3328
#define XB_TOPGEN   3392
#define XCD_BAR_WORDS 3456
#define XB_SPIN_CAP (1u << 18)

__device__ __forceinline__ unsigned xb_ld(unsigned* p)              { return __hip_atomic_load(p, __ATOMIC_RELAXED, __HIP_MEMORY_SCOPE_AGENT); }
__device__ __forceinline__ unsigned xb_add(unsigned* p, unsigned v) { return __hip_atomic_fetch_add(p, v, __ATOMIC_RELAXED, __HIP_MEMORY_SCOPE_AGENT); }
__device__ __forceinline__ unsigned xb_xcc_id() { return (unsigned)__builtin_amdgcn_s_getreg((3 << 11) | 20) & 0xFu; }
#define XB_SPIN(cond, bar) do { unsigned _sp = 0; while (cond) { __builtin_amdgcn_s_sleep(1); \
    if ((++_sp & 255u) == 0u) { if (xb_ld(&(bar)[XB_TMO])) break; if (_sp > XB_SPIN_CAP) { atomicAdd(&(bar)[XB_TMO], 1u); break; } } } } while (0)

struct XcdBarrier {
    unsigned* bar; unsigned x;
    volatile LAS unsigned* st;
};

__device__ __forceinline__ XcdBarrier xcd_barrier_post(unsigned* bar, volatile LAS unsigned* st) {
    XcdBarrier b; b.bar = bar; b.x = xb_xcc_id(); b.st = st;
    if (threadIdx.x == 0) (void)xb_add(&bar[XB_XCNT(b.x)], 1u);
    return b;
}
__device__ __forceinline__ void xcd_barrier_complete(unsigned* bar, unsigned x, unsigned& nloc, unsigned& nx) {
    const unsigned G = gridDim.x * gridDim.y * gridDim.z;
    unsigned sum, cnt, mine, sp = 0u;
    for (;;) {
        sum = 0u; cnt = 0u; mine = 0u;
#pragma unroll
        for (unsigned j = 0; j < 16; ++j) { const unsigned c = xb_ld(&bar[XB_XCNT(j)]); sum += c; cnt += (c > 0u) ? 1u : 0u; mine = (j == x) ? c : mine; }
        if (sum == G) break;
        __builtin_amdgcn_s_sleep(1);
        if ((++sp & 255u) == 0u) { if (xb_ld(&bar[XB_TMO])) break; if (sp > XB_SPIN_CAP) { atomicAdd(&bar[XB_TMO], 1u); break; } }
    }
    nloc = mine > 0u ? mine : 1u; nx = cnt > 0u ? cnt : 1u;
}

__device__ __forceinline__ void xcd_barrier(const XcdBarrier& b) {
    asm volatile("s_waitcnt vmcnt(0)" ::: "memory");
    __syncthreads();
    if (threadIdx.x == 0) {
        unsigned* bar = b.bar;
        __builtin_amdgcn_s_waitcnt(0);
        unsigned nloc = b.st[0], nx = b.st[1];
        if (nloc == 0u) { xcd_barrier_complete(bar, b.x, nloc, nx); b.st[0] = nloc; b.st[1] = nx; }
        const unsigned old = xb_add(&bar[XB_XSUB(b.x)], 1u);
        const unsigned gen = old / nloc;
        if (old + 1u == (gen + 1u) * nloc) {
            __builtin_amdgcn_fence(__ATOMIC_RELEASE, "agent");
            asm volatile("s_waitcnt vmcnt(0)" ::: "memory");
            const unsigned og = xb_add(&bar[XB_TOP], 1u);
            const unsigned tg = og / nx;
            if (og + 1u == (tg + 1u) * nx) xb_add(&bar[XB_TOPGEN], 1u);
            else XB_SPIN(xb_ld(&bar[XB_TOPGEN]) == tg, bar);
            __builtin_amdgcn_fence(__ATOMIC_ACQUIRE, "agent");
            xb_add(&bar[XB_XGEN(b.x)], 1u);
            asm volatile("s_waitcnt vmcnt(0)" ::: "memory");
        } else {
            XB_SPIN(xb_ld(&bar[XB_XGEN(b.x)]) == gen, bar);
            __builtin_amdgcn_fence(__ATOMIC_ACQUIRE, "agent");
            asm volatile("s_waitcnt vmcnt(0)" ::: "memory");
        }
    }
    __syncthreads();
}

struct Args { const float* in[17]; float* out; unsigned char* ws; int ph_lo, ph_hi; };
struct Frame {
    LAS unsigned char* lds;
    int tid, lane, wave, vcu, G, bx;
    const float* const* in;
    GAS float* X; GAS unsigned char* ws;
};
#define INP(F, k) ((const GAS float*)(F).in[k])
#define IN_X 0
#define IN_P 1
#define IN_RELB 2
#define IN_GMIXPRE 3
#define IN_WIN 4
#define IN_CONVW 5
#define IN_POOLW 6
#define IN_POOLS 7
#define IN_WOUT 8
#define IN_GMIXPOST 9
#define IN_GFFNPRE 10
#define IN_WGU 11
#define IN_WDOWN 12
#define IN_GFFNPOST 13
#define IN_GPLE 14
#define IN_WPLEG 15
#define IN_WPLEP 16

typedef pg8::f32x4 (&AccRef)[2][2][4][2];
typedef const pg8::f32x4 (&AccCRef)[2][2][4][2];
__device__ __forceinline__ float dot4(f32x4 a) { return (a[0] * a[0] + a[1] * a[1]) + (a[2] * a[2] + a[3] * a[3]); }

struct EpiZ {
    static constexpr bool PERM = true, AFTER_DRAIN = false;
    GAS bf16* Z; const GAS float* rssp;
    __device__ __forceinline__ void operator()(AccCRef acc, const pg8::Unit& u, int wr, int wc, int fr, int fq) const {
        const int row0 = u.pm * 256 + wr * 64 + fr, col0 = u.pn * 256 + wc * 32 + 8 * fq;
#pragma unroll
        for (int ai = 0; ai < 2; ++ai)
#pragma unroll
            for (int m = 0; m < 4; ++m) {
                const int row = row0 + ai * 128 + m * 16;
                const GAS f32x4* rp = (const GAS f32x4*)(rssp + (size_t)row * 16);
                const f32x4 a = rp[0], b = rp[1], c = rp[2], d = rp[3];
                const float ss = ((a[0] + a[1]) + (a[2] + a[3])) + ((b[0] + b[1]) + (b[2] + b[3])) + ((c[0] + c[1]) + (c[2] + c[3])) + ((d[0] + d[1]) + (d[2] + d[3]));
                const float rs = rsqrtf(ss * (1.0f / DM) + RMS_EPS);
                GAS bf16* rowp = Z + (size_t)row * ZP + col0;
#pragma unroll
                for (int bj = 0; bj < 2; ++bj) {
                    const f32x4 v0 = acc[ai][bj][m][0] * rs, v1 = acc[ai][bj][m][1] * rs;
                    v4u w; w.x = pk2(v0[0], v0[1]); w.y = pk2(v0[2], v0[3]); w.z = pk2(v1[0], v1[1]); w.w = pk2(v1[2], v1[3]);
                    *(GAS v4u*)(rowp + bj * 128) = w;
                }
            }
    }
};
struct EpiT {
    static constexpr bool PERM = true, AFTER_DRAIN = false;
    GAS bf16* T; GAS float* rssp;
    __device__ __forceinline__ void operator()(AccCRef acc, const pg8::Unit& u, int wr, int wc, int fr, int fq) const {
        const int row0 = u.pm * 256 + wr * 64 + fr, col0 = u.pn * 256 + wc * 32 + 8 * fq;
#pragma unroll
        for (int ai = 0; ai < 2; ++ai)
#pragma unroll
            for (int m = 0; m < 4; ++m) {
                const int row = row0 + ai * 128 + m * 16;
                GAS bf16* rowp = T + (size_t)row * DM + col0;
                float ss = 0.f;
#pragma unroll
                for (int bj = 0; bj < 2; ++bj) {
                    const f32x4 v0 = acc[ai][bj][m][0], v1 = acc[ai][bj][m][1];
                    ss += dot4(v0) + dot4(v1);
                    v4u w; w.x = pk2(v0[0], v0[1]); w.y = pk2(v0[2], v0[3]); w.z = pk2(v1[0], v1[1]); w.w = pk2(v1[2], v1[3]);
                    *(GAS v4u*)(rowp + bj * 128) = w;
                }
                ss += __shfl_xor(ss, 16); ss += __shfl_xor(ss, 32);
                if (fq == 0) rssp[(size_t)row * 16 + u.pn * 4 + wc] = ss;
            }
    }
};
struct EpiB {
    static constexpr bool PERM = true, AFTER_DRAIN = false;
    GAS bf16* T;
    __device__ __forceinline__ void operator()(AccCRef acc, const pg8::Unit& u, int wr, int wc, int fr, int fq) const {
        const int row0 = u.pm * 256 + wr * 64 + fr, col0 = u.pn * 256 + wc * 32 + 8 * fq;
#pragma unroll
        for (int ai = 0; ai < 2; ++ai)
#pragma unroll
            for (int m = 0; m < 4; ++m) {
                GAS bf16* rowp = T + (size_t)(row0 + ai * 128 + m * 16) * DM + col0;
#pragma unroll
                for (int bj = 0; bj < 2; ++bj) {
                    const f32x4 v0 = acc[ai][bj][m][0], v1 = acc[ai][bj][m][1];
                    v4u w; w.x = pk2(v0[0], v0[1]); w.y = pk2(v0[2], v0[3]); w.z = pk2(v1[0], v1[1]); w.w = pk2(v1[2], v1[3]);
                    *(GAS v4u*)(rowp + bj * 128) = w;
                }
            }
    }
};
struct EpiSwiGLU {
    static constexpr bool PERM = true, AFTER_DRAIN = false;
    GAS bf16* H; const GAS float* rss1;
    __device__ __forceinline__ void operator()(AccCRef acc, const pg8::Unit& u, int wr, int wc, int fr, int fq) const {
        const int row0 = u.pm * 256 + wr * 64 + fr, col0 = u.pn * 128 + wc * 32 + 8 * fq;
#pragma unroll
        for (int ai = 0; ai < 2; ++ai)
#pragma unroll
            for (int m = 0; m < 4; ++m) {
                const int row = row0 + ai * 128 + m * 16;
                const float rs = rsqrtf(rss1[row] * (1.0f / DM) + RMS_EPS);
                float h[8];
#pragma unroll
                for (int n = 0; n < 2; ++n)
#pragma unroll
                    for (int j = 0; j < 4; ++j) { const float g = acc[ai][0][m][n][j] * rs, up = acc[ai][1][m][n][j] * rs; h[n * 4 + j] = g * up * sigmoidf_(g); }
                v4u w; w.x = pk2(h[0], h[1]); w.y = pk2(h[2], h[3]); w.z = pk2(h[4], h[5]); w.w = pk2(h[6], h[7]);
                *(GAS v4u*)(H + (size_t)row * DFF + col0) = w;
            }
    }
};
struct EpiPLE {
    static constexpr bool PERM = false, AFTER_DRAIN = false;
    GAS float* X; GAS bf16* XB; const GAS bf16* T2; const GAS float* rss1; GAS float* rssp;
    __device__ __forceinline__ void operator()(AccCRef acc, const pg8::Unit& u, int wr, int wc, int fr, int fq) const {
        const int row0 = u.pm * 256 + wr * 64 + fr, col0 = u.pn * 256 + wc * 32 + 4 * fq;
#pragma unroll
        for (int ai = 0; ai < 2; ++ai)
#pragma unroll
            for (int m = 0; m < 4; ++m) {
                const int row = row0 + ai * 128 + m * 16;
                const float rs = rsqrtf(rss1[row] * (1.0f / DM) + RMS_EPS);
                float ss = 0.f;
#pragma unroll
                for (int bj = 0; bj < 2; ++bj)
#pragma unroll
                    for (int n = 0; n < 2; ++n) {
                        const size_t off = (size_t)row * DM + col0 + bj * 128 + n * 16;
                        const f32x4 xo = *(const GAS f32x4*)(X + off); const v2u t2 = *(const GAS v2u*)(T2 + off);
                        const f32x4 a = acc[ai][bj][m][n] * rs;
                        f32x4 xn;
                        xn[0] = xo[0] + sigmoidf_(a[0]) * bflo(t2.x); xn[1] = xo[1] + sigmoidf_(a[1]) * bfhi(t2.x);
                        xn[2] = xo[2] + sigmoidf_(a[2]) * bflo(t2.y); xn[3] = xo[3] + sigmoidf_(a[3]) * bfhi(t2.y);
                        ss += dot4(xn);
                        *(GAS f32x4*)(X + off) = xn;
                        v2u w; w.x = pk2(xn[0], xn[1]); w.y = pk2(xn[2], xn[3]); *(GAS v2u*)(XB + off) = w;
                    }
                ss += __shfl_xor(ss, 16); ss += __shfl_xor(ss, 32);
                if (fq == 0) rssp[(size_t)row * 16 + u.pn * 4 + wc] = ss;
            }
    }
};

__device__ __forceinline__ int win_src(int n) {
    if (n < 1280) return n;
    if (n < 1536) return 2376 + (n - 1280);
    if (n < 1792) return 1280 + (n - 1536);
    if (n < 2048) return 2632 + (n - 1792);
    if (n < 2304) return 1536 + (n - 2048);
    if (n < 2560) return 2888 + (n - 2304);
    if (n < 3072) return 1792 + (n - 2560);
    if (n < 3136) return 2304 + (n - 3072);
    if (n < 3144) return 2368 + (n - 3136);
    return -1;
}
template <int MAP>
__device__ __forceinline__ void tr_item(const GAS float* W, int K, int Nsrc, int Ndst, const GAS float* g, GAS bf16* WT, LAS float* scr, int item, int lane) {
    const int nblk = Ndst / 32, kb = item / nblk, nb = item % nblk, k0 = 64 * kb, n0 = 32 * nb;
    const int nd = n0 + (lane & 31);
    int ns; float cs = 1.0f;
    if (MAP == 0) ns = nd;
    else if (MAP == 1) { ns = win_src(nd); if (nd >= ZC_Q && nd < ZC_K) cs = C2; }
    else { const int pn = nd >> 8, r = nd & 255; ns = (r < 128) ? (pn * 128 + r) : (DFF + pn * 128 + (r - 128)); }
#pragma unroll 8
    for (int i = 0; i < 32; ++i) {
        const int kk = 2 * i + (lane >> 5);
        float v = 0.f;
        if (ns >= 0) v = W[(size_t)(k0 + kk) * Nsrc + ns] * cs;
        if (g) v *= g[k0 + kk];
        scr[kk * 33 + (lane & 31)] = v;
    }
    LDS_WAIT(); asm volatile("" ::: "memory");
    const int c = lane & 7;
#pragma unroll
    for (int j = 0; j < 4; ++j) {
        const int n = (lane >> 3) + 8 * j; const LAS float* s = scr + (8 * c) * 33 + n;
        v4u o; o.x = pk2(s[0 * 33], s[1 * 33]); o.y = pk2(s[2 * 33], s[3 * 33]); o.z = pk2(s[4 * 33], s[5 * 33]); o.w = pk2(s[6 * 33], s[7 * 33]);
        *(GAS v4u*)(WT + (size_t)(n0 + n) * K + k0 + 8 * c) = o;
    }
    LDS_WAIT(); asm volatile("" ::: "memory");
}
__device__ __forceinline__ void phase_prologue(const Frame& F) {
    LAS float* scr = (LAS float*)(F.lds + F.wave * 16384);
    const int gw = F.vcu * NWAVES + F.wave, NGW = F.G * NWAVES, lane = F.lane;
    constexpr int I_WIN = (DM / 64) * (ZP / 32), I_WOUT = (DM / 64) * (DM / 32), I_WGU = (DM / 64) * (2 * DFF / 32), I_WD = (DFF / 64) * (DM / 32), I_WG = I_WOUT, I_WP = (PLE / 64) * (DM / 32);
    constexpr int I_LAYER = I_WIN + I_WOUT + I_WGU + I_WD + I_WG + I_WP;
    for (int it = gw; it < DEPTH * I_LAYER; it += NGW) {
        const int L = it / I_LAYER; int r = it % I_LAYER;
        GAS unsigned char* wl = F.ws + WS_W + (size_t)L * LW_BYTES;
        if (r < I_WIN) { tr_item<1>(INP(F, IN_WIN) + (size_t)L * DM * NIN, DM, NIN, ZP, INP(F, IN_GMIXPRE) + L * DM, (GAS bf16*)(wl + LW_WIN), scr, r, lane); continue; } r -= I_WIN;
        if (r < I_WOUT) { tr_item<0>(INP(F, IN_WOUT) + (size_t)L * DM * DM, DM, DM, DM, nullptr, (GAS bf16*)(wl + LW_WOUT), scr, r, lane); continue; } r -= I_WOUT;
        if (r < I_WGU) { tr_item<2>(INP(F, IN_WGU) + (size_t)L * DM * 2 * DFF, DM, 2 * DFF, 2 * DFF, INP(F, IN_GFFNPRE) + L * DM, (GAS bf16*)(wl + LW_WGU), scr, r, lane); continue; } r -= I_WGU;
        if (r < I_WD) { tr_item<0>(INP(F, IN_WDOWN) + (size_t)L * DFF * DM, DFF, DM, DM, nullptr, (GAS bf16*)(wl + LW_WD), scr, r, lane); continue; } r -= I_WD;
        if (r < I_WG) { tr_item<0>(INP(F, IN_WPLEG) + (size_t)L * DM * DM, DM, DM, DM, INP(F, IN_GPLE) + L * DM, (GAS bf16*)(wl + LW_WG), scr, r, lane); continue; } r -= I_WG;
        tr_item<0>(INP(F, IN_WPLEP) + (size_t)L * PLE * DM, PLE, DM, DM, nullptr, (GAS bf16*)(wl + LW_WP), scr, r, lane);
    }
    {
        const GAS f32x4* src = (const GAS f32x4*)INP(F, IN_P); GAS v2u* dst = (GAS v2u*)(F.ws + WS_PB);
        const size_t n4 = (size_t)DEPTH * M * PLE / 4;
        for (size_t i = (size_t)F.vcu * NTHREADS + F.tid; i < n4; i += (size_t)F.G * NTHREADS) { const f32x4 v = src[i]; v2u w; w.x = pk2(v[0], v[1]); w.y = pk2(v[2], v[3]); dst[i] = w; }
    }
    {
        const GAS float* x = INP(F, IN_X); GAS bf16* XB = (GAS bf16*)(F.ws + WS_XB); GAS float* rssp = (GAS float*)(F.ws + WS_RSSPX);
        for (int row = gw; row < M; row += NGW) {
            const GAS f32x4* xr = (const GAS f32x4*)(x + (size_t)row * DM) + lane; GAS f32x4* xo = (GAS f32x4*)(F.X + (size_t)row * DM) + lane; GAS v2u* xb = (GAS v2u*)(XB + (size_t)row * DM) + lane;
            float ss = 0.f;
#pragma unroll
            for (int j = 0; j < 4; ++j) { const f32x4 v = xr[64 * j]; ss += dot4(v); xo[64 * j] = v; v2u w; w.x = pk2(v[0], v[1]); w.y = pk2(v[2], v[3]); xb[64 * j] = w; }
            ss = wave_sum(ss);
            if (lane < 16) rssp[(size_t)row * 16 + lane] = (lane == 0) ? ss : 0.f;
        }
    }
}

__device__ __forceinline__ void phase_resid(const Frame& F, const GAS bf16* T, const GAS float* rsspt, const GAS float* g) {
    const int gw = F.vcu * NWAVES + F.wave, NGW = F.G * NWAVES, lane = F.lane;
    GAS bf16* XB = (GAS bf16*)(F.ws + WS_XB); GAS float* rss1 = (GAS float*)(F.ws + WS_RSS1);
    f32x4 gv[4];
#pragma unroll
    for (int j = 0; j < 4; ++j) gv[j] = ((const GAS f32x4*)g)[lane + 64 * j];
    for (int row = gw; row < M; row += NGW) {
        const GAS f32x4* rp = (const GAS f32x4*)(rsspt + (size_t)row * 16);
        const f32x4 a = rp[0], b = rp[1], c = rp[2], d = rp[3];
        const float st = ((a[0] + a[1]) + (a[2] + a[3])) + ((b[0] + b[1]) + (b[2] + b[3])) + ((c[0] + c[1]) + (c[2] + c[3])) + ((d[0] + d[1]) + (d[2] + d[3]));
        const float rs = rsqrtf(st * (1.0f / DM) + RMS_EPS);
        GAS f32x4* xr = (GAS f32x4*)(F.X + (size_t)row * DM) + lane; const GAS v2u* tr = (const GAS v2u*)(T + (size_t)row * DM) + lane; GAS v2u* xb = (GAS v2u*)(XB + (size_t)row * DM) + lane;
        float ss = 0.f;
#pragma unroll
        for (int j = 0; j < 4; ++j) {
            f32x4 v = xr[64 * j]; const v2u t = tr[64 * j];
            v[0] += gv[j][0] * bflo(t.x) * rs; v[1] += gv[j][1] * bfhi(t.x) * rs; v[2] += gv[j][2] * bflo(t.y) * rs; v[3] += gv[j][3] * bfhi(t.y) * rs;
            ss += dot4(v); xr[64 * j] = v; v2u w; w.x = pk2(v[0], v[1]); w.y = pk2(v[2], v[3]); xb[64 * j] = w;
        }
        ss = wave_sum(ss);
        if (lane == 0) rss1[row] = ss;
    }
}

__device__ __forceinline__ void phase_prep(const Frame& F, int L) {
    const GAS bf16* Z = (const GAS bf16*)(F.ws + WS_RZ); GAS bf16* MIX = (GAS bf16*)(F.ws + WS_RM);
    const int tid = F.tid, lane = F.lane, wave = F.wave;
    {
        const GAS float* cw = INP(F, IN_CONVW) + (size_t)L * 3 * 256;
        for (size_t i = (size_t)F.vcu * NTHREADS + tid; i < (size_t)M * 32; i += (size_t)F.G * NTHREADS) {
            const int row = (int)(i >> 5), c0 = (int)(i & 31) * 8, t = row & (SEQ - 1);
            float accv[8];
#pragma unroll
            for (int e = 0; e < 8; ++e) accv[e] = 0.f;
#pragma unroll
            for (int j = 0; j < 3; ++j) {
                const int tt = t - 2 + j;
                if (tt >= 0) {
                    const GAS bf16* zr = Z + (size_t)(row - 2 + j) * ZP;
                    const v4u ain = *(const GAS v4u*)(zr + ZC_AIN + c0), ac = *(const GAS v4u*)(zr + ZC_AC + c0);
                    const f32x4 w0 = *(const GAS f32x4*)(cw + j * 256 + c0), w1 = *(const GAS f32x4*)(cw + j * 256 + c0 + 4);
                    accv[0] += w0[0] * bflo(ain.x) * bflo(ac.x); accv[1] += w0[1] * bfhi(ain.x) * bfhi(ac.x);
                    accv[2] += w0[2] * bflo(ain.y) * bflo(ac.y); accv[3] += w0[3] * bfhi(ain.y) * bfhi(ac.y);
                    accv[4] += w1[0] * bflo(ain.z) * bflo(ac.z); accv[5] += w1[1] * bfhi(ain.z) * bfhi(ac.z);
                    accv[6] += w1[2] * bflo(ain.w) * bflo(ac.w); accv[7] += w1[3] * bfhi(ain.w) * bfhi(ac.w);
                }
            }
            const v4u ab = *(const GAS v4u*)(Z + (size_t)row * ZP + ZC_AB + c0);
            v4u o; o.x = pk2(accv[0] * bflo(ab.x), accv[1] * bfhi(ab.x)); o.y = pk2(accv[2] * bflo(ab.y), accv[3] * bfhi(ab.y));
            o.z = pk2(accv[4] * bflo(ab.z), accv[5] * bfhi(ab.z)); o.w = pk2(accv[6] * bflo(ab.w), accv[7] * bfhi(ab.w));
            *(GAS v4u*)(MIX + (size_t)row * DM + c0) = o;
        }
    }
    {
        LAS float* Vs = (LAS float*)F.lds; LAS float* Ds = (LAS float*)(F.lds + 49152);
        const GAS float* pw = INP(F, IN_POOLW) + (size_t)L * 4 * 64 * 64; const GAS float* ps = INP(F, IN_POOLS) + (size_t)L * 256;
        const int oc = tid & 255, og = oc >> 6, oo = oc & 63, th = tid >> 8;
        float wreg[64];
#pragma unroll
        for (int c = 0; c < 64; ++c) wreg[c] = pw[(og * 64 + c) * 64 + oo];
        const float psc = ps[oc];
        for (int tile = F.vcu; tile < M / 32; tile += F.G) {
            const int row0 = tile * 32, t0 = row0 & (SEQ - 1);
            __syncthreads();
            for (int i = tid; i < 48 * 32; i += NTHREADS) {
                const int r = i >> 5, c0 = (i & 31) * 8, tt = t0 - 16 + r;
                float v[8];
                if (tt >= 0) { const v4u z = *(const GAS v4u*)(Z + (size_t)(row0 - 16 + r) * ZP + ZC_PV + c0);
                    v[0] = bflo(z.x); v[1] = bfhi(z.x); v[2] = bflo(z.y); v[3] = bfhi(z.y); v[4] = bflo(z.z); v[5] = bfhi(z.z); v[6] = bflo(z.w); v[7] = bfhi(z.w); }
                else {
#pragma unroll
                    for (int e = 0; e < 8; ++e) v[e] = 0.f; }
#pragma unroll
                for (int e = 0; e < 8; ++e) Vs[r * 256 + c0 + e] = v[e];
            }
            __syncthreads();
            {
                const int w = 2 << og;
                for (int tl = th * 16; tl < th * 16 + 16; ++tl) {
                    float s = 0.f;
                    for (int j = 0; j < w; ++j) s += Vs[(tl + 16 - j) * 256 + oc];
                    const int tg = t0 + tl; const int cnt = (tg + 1 < w) ? (tg + 1) : w;
                    Ds[tl * 256 + oc] = s / (float)cnt - Vs[(tl + 16) * 256 + oc];
                }
            }
            __syncthreads();
            for (int tl = th * 16; tl < th * 16 + 16; ++tl) {
                const LAS f32x4* dr = (const LAS f32x4*)(Ds + tl * 256 + og * 64);
                float a = 0.f;
#pragma unroll
                for (int c4 = 0; c4 < 16; ++c4) { const f32x4 d = dr[c4]; a += d[0] * wreg[4 * c4] + d[1] * wreg[4 * c4 + 1] + d[2] * wreg[4 * c4 + 2] + d[3] * wreg[4 * c4 + 3]; }
                MIX[(size_t)(row0 + tl) * DM + 256 + oc] = (bf16)f2bf(a * psc);
            }
        }
        __syncthreads();
    }
    {
        GAS bf16* Vt = (GAS bf16*)(F.ws + WS_VT);
        LAS bf16* tl = (LAS bf16*)(F.lds + wave * 16384);
        const int gw = F.vcu * NWAVES + wave, NGW = F.G * NWAVES;
        for (int it = gw; it < NB * 8 * (SEQ / 64); it += NGW) {
            const int st = it & 63, bh = it >> 6, b = bh >> 3, h = bh & 7;
            const GAS bf16* src = Z + (size_t)(b * SEQ + st * 64 + lane) * ZP + ZC_V + h * 64;
#pragma unroll
            for (int c = 0; c < 8; ++c) { const v4u v = *(const GAS v4u*)(src + c * 8);
                const unsigned ww[4] = {v.x, v.y, v.z, v.w};
#pragma unroll
                for (int e = 0; e < 4; ++e) { tl[(c * 8 + 2 * e) * 66 + lane] = (bf16)(ww[e] & 0xffffu); tl[(c * 8 + 2 * e + 1) * 66 + lane] = (bf16)(ww[e] >> 16); } }
            LDS_WAIT(); asm volatile("" ::: "memory");
            GAS bf16* dst = Vt + ((size_t)bh * 64 + lane) * SEQ + st * 64;
#pragma unroll
            for (int c = 0; c < 8; ++c) { v4u o; const LAS unsigned* s = (const LAS unsigned*)(tl + lane * 66 + c * 8); o.x = s[0]; o.y = s[1]; o.z = s[2]; o.w = s[3]; *(GAS v4u*)(dst + c * 8) = o; }
            LDS_WAIT(); asm volatile("" ::: "memory");
        }
    }
    {
        GAS float* KM = (GAS float*)(F.ws + WS_KM);
        LAS float* red = (LAS float*)F.lds;
        for (int it = F.vcu; it < NB * 16; it += F.G) {
            const int cg = tid & 31, rg = tid >> 5;
            const GAS bf16* src = Z + (size_t)(it * 256 + rg * 16) * ZP + ZC_K + 256 + cg * 8;
            float s[8];
#pragma unroll
            for (int e = 0; e < 8; ++e) s[e] = 0.f;
#pragma unroll 4
            for (int r = 0; r < 16; ++r) { const v4u v = *(const GAS v4u*)(src + (size_t)r * ZP);
                s[0] += bflo(v.x); s[1] += bfhi(v.x); s[2] += bflo(v.y); s[3] += bfhi(v.y); s[4] += bflo(v.z); s[5] += bfhi(v.z); s[6] += bflo(v.w); s[7] += bfhi(v.w); }
            __syncthreads();
#pragma unroll
            for (int e = 0; e < 8; ++e) red[rg * 256 + cg * 8 + e] = s[e];
            __syncthreads();
            if (tid < 256) { float a = 0.f;
#pragma unroll
                for (int g = 0; g < 16; ++g) a += red[g * 256 + tid];
                KM[(size_t)it * 256 + tid] = a * (1.0f / 256.0f); }
        }
        __syncthreads();
    }
}

typedef unsigned short u16x2 __attribute__((ext_vector_type(2)));
__device__ __forceinline__ void cnt_acc(unsigned& acc, unsigned w, unsigned kk) { acc = __builtin_amdgcn_udot4((w + kk) & 0x80008000u, 0x01010101u, acc, false); }
__device__ __forceinline__ void cnt_acc4(unsigned& acc, v4u v, unsigned kk) { cnt_acc(acc, v.x, kk); cnt_acc(acc, v.y, kk); cnt_acc(acc, v.z, kk); cnt_acc(acc, v.w, kk); }
template <int CTRL, int ROWMASK> __device__ __forceinline__ unsigned dpp_add(unsigned v) { return v + (unsigned)__builtin_amdgcn_update_dpp(0, (int)v, CTRL, ROWMASK, 0xf, false); }
__device__ __forceinline__ unsigned wave_scan_incl(unsigned v) {
    v = dpp_add<0x111, 0xf>(v); v = dpp_add<0x112, 0xf>(v); v = dpp_add<0x114, 0xf>(v); v = dpp_add<0x118, 0xf>(v);
    v = dpp_add<0x142, 0xa>(v); v = dpp_add<0x143, 0xc>(v);
    return v;
}
__device__ __forceinline__ unsigned wave_total(unsigned v) { return (unsigned)__builtin_amdgcn_readlane((int)wave_scan_incl(v), 63); }
__device__ __forceinline__ void count_ge2(const LAS unsigned short* rowA, const LAS unsigned short* rowB, int nchunks, unsigned candA, unsigned candB, int lane, unsigned& cA, unsigned& cB) {
    const unsigned ka = 0x8000u - candA, kb = 0x8000u - candB;
    const unsigned kkA = ka | (ka << 16), kkB = kb | (kb << 16);
    unsigned accA = 0, accB = 0, accA2 = 0, accB2 = 0;
    const LAS unsigned short* pa = rowA + lane * 8; const LAS unsigned short* pb = rowB + lane * 8;
    int c = 0;
    for (; c + 2 <= nchunks; c += 2) {
        const v4u va = *(const LAS v4u*)(pa + c * 512), vb = *(const LAS v4u*)(pb + c * 512), va2 = *(const LAS v4u*)(pa + c * 512 + 512), vb2 = *(const LAS v4u*)(pb + c * 512 + 512);
        cnt_acc4(accA, va, kkA); cnt_acc4(accB, vb, kkB); cnt_acc4(accA2, va2, kkA); cnt_acc4(accB2, vb2, kkB);
    }
    if (c < nchunks) { const v4u va = *(const LAS v4u*)(pa + c * 512), vb = *(const LAS v4u*)(pb + c * 512); cnt_acc4(accA, va, kkA); cnt_acc4(accB, vb, kkB); }
    cA = wave_total((accA + accA2) >> 7); cB = wave_total((accB + accB2) >> 7);
}
__device__ __forceinline__ void idx_tile(const Frame& F, int b, int qt) {
    const GAS bf16* Z = (const GAS bf16*)(F.ws + WS_RZ); GAS u64* DMK = (GAS u64*)(F.ws + WS_DMASK);
    LAS unsigned short* keys = (LAS unsigned short*)F.lds; LAS unsigned char* mrow = (LAS unsigned char*)(F.lds + IDX_MROW_OFF);
    const int tid = F.tid, lane = F.lane, wave = F.wave, q0 = qt * 16;
    if (qt < 16) {
        for (int i = tid; i < 16 * 512; i += NTHREADS) { const int qi = i >> 9, bi = i & 511, q = q0 + qi, k0 = bi * 8;
            mrow[i] = (unsigned char)((k0 + 7 <= q) ? 0xFFu : ((k0 > q) ? 0u : ((1u << (q - k0 + 1)) - 1u))); }
    } else {
        const int nchunks = (q0 + 16 + 511) >> 9;
        const size_t rb = (size_t)b * SEQ;
#ifndef IDX_REP_SCORE
#define IDX_REP_SCORE 1
#endif
#ifndef IDX_REP_SEL
#define IDX_REP_SEL 1
#endif
        for (int rep_ = 0; rep_ < IDX_REP_SCORE; ++rep_)
        {
            const int fr = lane & 15, fq = lane >> 4;
            bf16x8 Bq[8][2];
            const GAS bf16* qrow = Z + (rb + q0 + fr) * ZP + ZC_IQ + fq * 8;
#pragma unroll
            for (int h = 0; h < 8; ++h)
#pragma unroll
                for (int ks = 0; ks < 2; ++ks) Bq[h][ks] = *(const GAS bf16x8*)(qrow + h * 64 + ks * 32);
            float iw[8];
            { const v4u w = *(const GAS v4u*)(Z + (rb + q0 + fr) * ZP + ZC_IW);
              iw[0] = bflo(w.x); iw[1] = bfhi(w.x); iw[2] = bflo(w.y); iw[3] = bfhi(w.y); iw[4] = bflo(w.z); iw[5] = bfhi(w.z); iw[6] = bflo(w.w); iw[7] = bfhi(w.w); }
            const int ntl = qt + 1, ntl_pad = nchunks * 32;
            const GAS bf16* kbase = Z + (rb + fr) * ZP + ZC_IK + fq * 8;
            bf16x8 A0n, A1n, A0m, A1m;
            { const GAS bf16* krow = kbase + (size_t)(wave * 16) * ZP; A0n = *(const GAS bf16x8*)(krow); A1n = *(const GAS bf16x8*)(krow + 32); }
            { const GAS bf16* krow = kbase + (size_t)((wave + NWAVES) * 16) * ZP; A0m = *(const GAS bf16x8*)(krow); A1m = *(const GAS bf16x8*)(krow + 32); }
            for (int kt = wave; kt < ntl_pad; kt += NWAVES) {
                v2u outw;
                if (kt < ntl) {
                    const bf16x8 A0 = A0n, A1 = A1n;
                    A0n = A0m; A1n = A1m;
                    if (kt + 2 * NWAVES < ntl) { const GAS bf16* krow = kbase + (size_t)((kt + 2 * NWAVES) * 16) * ZP; A0m = *(const GAS bf16x8*)(krow); A1m = *(const GAS bf16x8*)(krow + 32); }
                    float sc[4] = {0.f, 0.f, 0.f, 0.f};
#pragma unroll
                    for (int h = 0; h < 8; ++h) {
                        pg8::f32x4 acc = {0.f, 0.f, 0.f, 0.f};
                        acc = __builtin_amdgcn_mfma_f32_16x16x32_bf16(A0, Bq[h][0], acc, 0, 0, 0);
                        acc = __builtin_amdgcn_mfma_f32_16x16x32_bf16(A1, Bq[h][1], acc, 0, 0, 0);
#pragma unroll
                        for (int i = 0; i < 4; ++i) { const float av = acc[i]; int ai = __builtin_bit_cast(int, av); ai = ai < 0 ? 0 : ai;
                            sc[i] += iw[h] * __builtin_bit_cast(float, ai); }
                    }
                    typedef _Float16 h2 __attribute__((ext_vector_type(2))); typedef short s2 __attribute__((ext_vector_type(2)));
                    const h2 p01 = {(_Float16)sc[0], (_Float16)sc[1]}, p23 = {(_Float16)sc[2], (_Float16)sc[3]};
                    const unsigned x01 = __builtin_bit_cast(unsigned, p01), x23 = __builtin_bit_cast(unsigned, p23);
                    const s2 g01 = __builtin_bit_cast(s2, x01) >> 15, g23 = __builtin_bit_cast(s2, x23) >> 15;
                    unsigned m01 = ((x01 ^ (__builtin_bit_cast(unsigned, g01) | 0x80008000u)) >> 1) & 0x7fff7fffu;
                    unsigned m23 = ((x23 ^ (__builtin_bit_cast(unsigned, g23) | 0x80008000u)) >> 1) & 0x7fff7fffu;
                    if (kt >= qt) {
                        const int kq = kt * 16 + fq * 4 - (q0 + fr);
                        if (kq > 0) m01 &= 0xffff0000u; if (kq + 1 > 0) m01 &= 0x0000ffffu; if (kq + 2 > 0) m23 &= 0xffff0000u; if (kq + 3 > 0) m23 &= 0x0000ffffu;
                    }
                    outw.x = m01; outw.y = m23;
                } else { outw.x = 0u; outw.y = 0u; }
                *(LAS v2u*)(keys + fr * 4096 + kt * 16 + fq * 4) = outw;
            }
        }
        __syncthreads();
        for (int rep_ = 0; rep_ < IDX_REP_SEL; ++rep_)
        {
            const int qa = wave, qb = wave + 8;
            const LAS unsigned short* rowA = keys + qa * 4096; const LAS unsigned short* rowB = keys + qb * 4096;
            unsigned TA = 0, TB = 0;
            for (int bit = 14; bit >= 0; --bit) {
                const unsigned ca = TA | (1u << bit), cb = TB | (1u << bit); unsigned na, nb;
                count_ge2(rowA, rowB, nchunks, ca, cb, lane, na, nb);
                if (na >= 256u) TA = ca; if (nb >= 256u) TB = cb;
            }
            unsigned gA, gB;
            count_ge2(rowA, rowB, nchunks, TA + 1u, TB + 1u, lane, gA, gB);
            const unsigned needA = 256u - gA, needB = 256u - gB;
            unsigned baseA = 0, baseB = 0;
            LAS unsigned char* mrA = mrow + qa * 512; LAS unsigned char* mrB = mrow + qb * 512;
            for (int c = 0; c < nchunks; ++c) {
#pragma unroll
                for (int s = 0; s < 2; ++s) {
                    const LAS unsigned short* row = s ? rowB : rowA; const unsigned T = s ? TB : TA, need = s ? needB : needA; unsigned& base = s ? baseB : baseA; LAS unsigned char* mr = s ? mrB : mrA;
                    const v4u v = *(const LAS v4u*)(row + c * 512 + lane * 8);
                    const unsigned ww[4] = {v.x, v.y, v.z, v.w};
                    unsigned gtb = 0, eqb = 0;
#pragma unroll
                    for (int e = 0; e < 4; ++e) { const unsigned lo = ww[e] & 0xffffu, hi = ww[e] >> 16;
                        gtb |= (lo > T ? 1u : 0u) << (2 * e); gtb |= (hi > T ? 1u : 0u) << (2 * e + 1);
                        eqb |= (lo == T ? 1u : 0u) << (2 * e); eqb |= (hi == T ? 1u : 0u) << (2 * e + 1); }
                    const unsigned ecount = (unsigned)__builtin_popcount(eqb);
                    const unsigned incl = wave_scan_incl(ecount);
                    const unsigned rank0 = base + incl - ecount; unsigned sel = gtb;
                    const int allow = (int)need - (int)rank0;
                    if (allow >= (int)ecount) sel |= eqb;
                    else if (allow > 0) { unsigned rank = 0;
#pragma unroll
                        for (int j = 0; j < 8; ++j) { if ((eqb >> j) & 1u) { if ((int)rank < allow) sel |= 1u << j; ++rank; } } }
                    mr[c * 64 + lane] = (unsigned char)sel;
                    base += (unsigned)__builtin_amdgcn_readlane((int)incl, 63);
                }
            }
            for (int i = nchunks * 64 + lane; i < 512; i += 64) { mrA[i] = 0; mrB[i] = 0; }
        }
    }
    __syncthreads();
    for (int i = tid; i < 1024; i += NTHREADS) { const int t64 = i >> 4, qi = i & 15;
        const LAS unsigned* s = (const LAS unsigned*)(mrow + qi * 512 + t64 * 8);
        DMK[((size_t)(b * 64 + t64)) * SEQ + q0 + qi] = (u64)s[0] | ((u64)s[1] << 32); }
    __syncthreads();
}
__device__ __forceinline__ void phase_index(const Frame& F) {
    for (int pi = F.vcu; pi < 512; pi += F.G) { const int b = pi >> 7, s = pi & 127; idx_tile(F, b, s); idx_tile(F, b, 255 - s); }
}

__device__ __forceinline__ int crow(int r, int hi) { return (r & 3) + 8 * (r >> 2) + 4 * hi; }
__device__ __forceinline__ unsigned cvtpk(float lo, float hi) { typedef float f2 __attribute__((ext_vector_type(2))); typedef __bf16 b2 __attribute__((ext_vector_type(2)));
    f2 v = {lo, hi}; b2 b = __builtin_convertvector(v, b2); return __builtin_bit_cast(unsigned, b); }
#define MFMA32(a, b, c) __builtin_amdgcn_mfma_f32_32x32x16_bf16((a), (b), (c), 0, 0, 0)
__device__ __forceinline__ void attn_unit(const Frame& F, int b, int h8, int qb) {
    const GAS bf16* Z = (const GAS bf16*)(F.ws + WS_RZ); const GAS bf16* Vt = (const GAS bf16*)(F.ws + WS_VT); const GAS u64* DMK = (const GAS u64*)(F.ws + WS_DMASK);
    const GAS float* KM = (const GAS float*)(F.ws + WS_KM); GAS bf16* MIX = (GAS bf16*)(F.ws + WS_RM);
    LAS unsigned char* lds = F.lds; const LAS float* biasT = (const LAS float*)(F.lds + 32768) + h8 * 128;
    const int tid = F.tid, lane = F.lane, w = F.wave, r32 = lane & 31, hi = lane >> 5;
    const bool moba = h8 >= 4;
    const int q0 = qb * 256, qw0 = q0 + w * 32, q = qw0 + r32;
    const size_t rb = (size_t)b * SEQ;
    bf16x8 qf[4];
    { const GAS bf16* Qp = Z + (rb + q) * ZP + ZC_Q + h8 * 64 + 8 * hi;
#pragma unroll
      for (int d0 = 0; d0 < 4; ++d0) qf[d0] = *(const GAS bf16x8*)(Qp + 16 * d0); }
    unsigned selmask = 0;
    if (moba && qb > 0) {
        float qv[64];
        { const GAS bf16* Qr = Z + (rb + q) * ZP + ZC_Q + h8 * 64;
#pragma unroll
          for (int c = 0; c < 8; ++c) { const v4u v = *(const GAS v4u*)(Qr + c * 8);
              qv[c * 8 + 0] = bflo(v.x); qv[c * 8 + 1] = bfhi(v.x); qv[c * 8 + 2] = bflo(v.y); qv[c * 8 + 3] = bfhi(v.y); qv[c * 8 + 4] = bflo(v.z); qv[c * 8 + 5] = bfhi(v.z); qv[c * 8 + 6] = bflo(v.w); qv[c * 8 + 7] = bfhi(v.w); } }
        float g0 = -INFINITY, g1 = -INFINITY, g2 = -INFINITY; int i0 = -1, i1 = -1, i2 = -1;
        for (int n = 0; n < qb; ++n) {
            const GAS float* km = KM + ((size_t)(b * 16 + n) * 4 + (h8 - 4)) * 64;
            float g = 0.f;
#pragma unroll
            for (int d = 0; d < 64; ++d) g += qv[d] * km[d];
            if (g > g0) { g2 = g1; i2 = i1; g1 = g0; i1 = i0; g0 = g; i0 = n; }
            else if (g > g1) { g2 = g1; i2 = i1; g1 = g; i1 = n; }
            else if (g > g2) { g2 = g; i2 = n; }
        }
        if (i0 >= 0) selmask |= 1u << i0; if (i1 >= 0) selmask |= 1u << i1; if (i2 >= 0) selmask |= 1u << i2;
    }
    f32x16 o0, o1;
#pragma unroll
    for (int r = 0; r < 16; ++r) { o0[r] = 0.f; o1[r] = 0.f; }
    float mrun = 0.f, lrun = 0.f;
    const float biasfar = biasT[127];
    const int ntiles = 4 * (qb + 1);
    const int lrow = tid >> 3, lch = tid & 7;
    const GAS bf16* Kg = Z + (rb + lrow) * ZP + ZC_K + h8 * 64 + lch * 8;
    const GAS bf16* Vg = Vt + ((size_t)(b * 8 + h8) * 64 + lrow) * SEQ + lch * 8;
    const int st_off = lrow * 128 + ((lch ^ (lrow & 7)) << 4);
    v4u kreg = *(const GAS v4u*)Kg, vreg = *(const GAS v4u*)Vg;
    for (int t = 0; t < ntiles; ++t) {
        const int buf = (t & 1) * 8192;
        *(LAS v4u*)(lds + buf + st_off) = kreg; *(LAS v4u*)(lds + 16384 + buf + st_off) = vreg;
        __syncthreads();
        if (t + 1 < ntiles) { kreg = *(const GAS v4u*)(Kg + (size_t)(t + 1) * 64 * ZP); vreg = *(const GAS v4u*)(Vg + (t + 1) * 64); }
        if (64 * t > qw0 + 31) continue;
        u64 word;
        if (!moba) word = DMK[((size_t)(b * 64 + t)) * SEQ + q];
        else { const int blk = t >> 2;
            if (blk == qb) { const int rel = q - 64 * t; word = (rel >= 63) ? ~0ull : ((rel < 0) ? 0ull : ((2ull << rel) - 1ull)); }
            else word = ((selmask >> blk) & 1u) ? ~0ull : 0ull; }
        if (__all(word == 0ull)) continue;
        const bool nearT = (qw0 - (64 * t + 63)) < 113;
        const float cinit = nearT ? 0.f : biasfar;
        f32x16 p0, p1;
#pragma unroll
        for (int r = 0; r < 16; ++r) { p0[r] = cinit; p1[r] = cinit; }
        { const LAS unsigned char* Kb = lds + buf + r32 * 128;
#pragma unroll
          for (int d0 = 0; d0 < 4; ++d0) {
              const int ch = ((2 * d0 + hi) ^ (r32 & 7)) << 4;
              const bf16x8 ka = *(const LAS bf16x8*)(Kb + ch), kb2 = *(const LAS bf16x8*)(Kb + 4096 + ch);
              p0 = MFMA32(ka, qf[d0], p0); p1 = MFMA32(kb2, qf[d0], p1); } }
        const unsigned wlo = (unsigned)word, whi = (unsigned)(word >> 32);
        if (nearT) {
            const int dbase = q - 64 * t;
#pragma unroll
            for (int r = 0; r < 16; ++r) { const int d0_ = dbase - crow(r, hi), d1_ = d0_ - 32;
                p0[r] += biasT[d0_ < 0 ? 0 : (d0_ > 127 ? 127 : d0_)]; p1[r] += biasT[d1_ < 0 ? 0 : (d1_ > 127 ? 127 : d1_)]; }
        }
#pragma unroll
        for (int r = 0; r < 16; ++r) { const int kv = crow(r, hi);
            if (!((wlo >> kv) & 1u)) p0[r] = -INFINITY; if (!((whi >> kv) & 1u)) p1[r] = -INFINITY; }
        float mx = fmaxf(p0[0], p1[0]);
#pragma unroll
        for (int r = 1; r < 16; ++r) mx = fmaxf(mx, fmaxf(p0[r], p1[r]));
        mx = fmaxf(mx, __shfl_xor(mx, 32));
        const float mnew = fmaxf(mrun, mx), alpha = __builtin_amdgcn_exp2f(mrun - mnew);
        mrun = mnew;
        float ls = 0.f;
#pragma unroll
        for (int r = 0; r < 16; ++r) { p0[r] = __builtin_amdgcn_exp2f(p0[r] - mnew); p1[r] = __builtin_amdgcn_exp2f(p1[r] - mnew); ls += p0[r] + p1[r]; o0[r] *= alpha; o1[r] *= alpha; }
        lrun = lrun * alpha + ls;
        bf16x8 pf[4];
        { v4u a; a.x = cvtpk(p0[0], p0[1]); a.y = cvtpk(p0[2], p0[3]); a.z = cvtpk(p0[4], p0[5]); a.w = cvtpk(p0[6], p0[7]); pf[0] = __builtin_bit_cast(bf16x8, a);
          a.x = cvtpk(p0[8], p0[9]); a.y = cvtpk(p0[10], p0[11]); a.z = cvtpk(p0[12], p0[13]); a.w = cvtpk(p0[14], p0[15]); pf[1] = __builtin_bit_cast(bf16x8, a);
          a.x = cvtpk(p1[0], p1[1]); a.y = cvtpk(p1[2], p1[3]); a.z = cvtpk(p1[4], p1[5]); a.w = cvtpk(p1[6], p1[7]); pf[2] = __builtin_bit_cast(bf16x8, a);
          a.x = cvtpk(p1[8], p1[9]); a.y = cvtpk(p1[10], p1[11]); a.z = cvtpk(p1[12], p1[13]); a.w = cvtpk(p1[14], p1[15]); pf[3] = __builtin_bit_cast(bf16x8, a); }
        { const LAS unsigned char* Vb = lds + 16384 + buf + r32 * 128 + 8 * hi;
#pragma unroll
          for (int ks = 0; ks < 4; ++ks) {
              const int c0 = 2 * ks;
              const int ca = ((c0 ^ (r32 & 7)) << 4), cb = (((c0 + 1) ^ (r32 & 7)) << 4);
              const s16x4 a0 = *(const LAS s16x4*)(Vb + ca), a1 = *(const LAS s16x4*)(Vb + cb);
              const s16x4 b0 = *(const LAS s16x4*)(Vb + 4096 + ca), b1 = *(const LAS s16x4*)(Vb + 4096 + cb);
              const bf16x8 va = __builtin_shufflevector(a0, a1, 0, 1, 2, 3, 4, 5, 6, 7), vb = __builtin_shufflevector(b0, b1, 0, 1, 2, 3, 4, 5, 6, 7);
              o0 = MFMA32(va, pf[ks], o0); o1 = MFMA32(vb, pf[ks], o1); } }
    }
    lrun += __shfl_xor(lrun, 32);
    const float rl = 1.0f / lrun;
    GAS bf16* orow = MIX + (rb + q) * DM + 512 + h8 * 64 + 4 * hi;
#pragma unroll
    for (int g = 0; g < 4; ++g) {
        v2u a; a.x = pk2(o0[4 * g] * rl, o0[4 * g + 1] * rl); a.y = pk2(o0[4 * g + 2] * rl, o0[4 * g + 3] * rl); *(GAS v2u*)(orow + 8 * g) = a;
        v2u c; c.x = pk2(o1[4 * g] * rl, o1[4 * g + 1] * rl); c.y = pk2(o1[4 * g + 2] * rl, o1[4 * g + 3] * rl); *(GAS v2u*)(orow + 32 + 8 * g) = c;
    }
    __syncthreads();
}
__device__ __forceinline__ void phase_attn(const Frame& F) {
    { LAS float* bt = (LAS float*)(F.lds + 32768); const GAS float* rbias = INP(F, IN_RELB);
      const int th[16] = {16, 19, 21, 24, 27, 31, 35, 40, 46, 52, 59, 67, 77, 87, 99, 113};
      for (int i = F.tid; i < 8 * 128; i += NTHREADS) { const int h = i >> 7, d = i & 127; int bk = d;
          if (d >= 16) { bk = 15;
#pragma unroll
              for (int k = 0; k < 16; ++k) bk += (d >= th[k]) ? 1 : 0; }
          bt[i] = rbias[h * 32 + bk] * LOG2E; }
      __syncthreads(); }
    for (int pi = F.vcu; pi < 256; pi += F.G) { const int bh = pi >> 3, s = pi & 7; attn_unit(F, bh >> 3, bh & 7, s); attn_unit(F, bh >> 3, bh & 7, 15 - s); }
}

constexpr int NPHASES = 1 + 9 * DEPTH;
#ifndef PH_MASK
#define PH_MASK 0x3ff
#endif
#define PHM(k) ((PH_MASK >> (k)) & 1)
#ifndef MK_ONE_LAUNCH
#define MK_ONE_LAUNCH 1
#endif
__device__ __forceinline__ Frame relaunder(const Frame& F0) {
    Frame F = F0; int t; asm volatile("v_mbcnt_lo_u32_b32 %0, -1, 0\n\tv_mbcnt_hi_u32_b32 %0, -1, %0\n\tv_lshl_add_u32 %0, %1, 6, %0" : "=&v"(t) : "s"(F0.wave)); F.tid = t; F.lane = t & 63; F.wave = __builtin_amdgcn_readfirstlane(t >> 6);
    asm volatile("" : "+s"(F.ws)); asm volatile("" : "+s"(F.X)); asm volatile("" : "+s"(F.G)); asm volatile("" : "+s"(F.vcu)); asm volatile("" : "+s"(F.bx));
    return F; }
__global__ void __launch_bounds__(NTHREADS, 2) fwd(Args args) {
    extern __shared__ __attribute__((aligned(16))) unsigned char lds_raw[];
    Frame F;
    F.lds = (LAS unsigned char*)lds_raw;
    F.tid = threadIdx.x; F.lane = F.tid & 63; F.wave = __builtin_amdgcn_readfirstlane(F.tid >> 6);
    F.G = gridDim.x; F.bx = blockIdx.x; { const int bx = blockIdx.x; F.vcu = (F.G % 8 == 0) ? (bx % 8) * (F.G / 8) + bx / 8 : bx; }
    F.in = args.in; F.X = (GAS float*)args.out; F.ws = (GAS unsigned char*)args.ws;
    if (F.tid < 4) ((LAS unsigned*)(F.lds + MISC_OFF))[F.tid] = 0u;
    __syncthreads();
    const int lo = args.ph_lo, hi = args.ph_hi;
    if (hi - lo > 1) (void)xcd_barrier_post((unsigned*)(args.ws + WS_CTL), (volatile LAS unsigned*)(F.lds + MISC_OFF));
#define IN(k) (lo <= (k) && (k) < hi)
#define XBAR() do { GAS unsigned char* wsb = (GAS unsigned char*)args.ws; asm volatile("" : "+s"(wsb)); XcdBarrier b_; b_.bar = (unsigned*)(wsb + WS_CTL); b_.x = xb_xcc_id(); b_.st = (volatile LAS unsigned*)(F.lds + MISC_OFF); xcd_barrier(b_); } while (0)
#define SEAM(k) do { if (IN(k) && IN((k) + 1)) { GAS unsigned char* wsb = (GAS unsigned char*)args.ws; asm volatile("" : "+s"(wsb)); XcdBarrier b_; b_.bar = (unsigned*)(wsb + WS_CTL); b_.x = xb_xcc_id(); b_.st = (volatile LAS unsigned*)(F.lds + MISC_OFF); xcd_barrier(b_); } } while (0)
    GAS unsigned char* const ws = (GAS unsigned char*)args.ws;
    if (PHM(0) && IN(0)) { const Frame Fl = relaunder(F); phase_prologue(Fl); }
    SEAM(0);

    { constexpr int L = 0;
    {
        const int p0 = 1 + 9 * L;
        GAS unsigned char* wl = ws + WS_W + (size_t)L * LW_BYTES;
        if (PHM(1) && IN(p0 + 0)) {
            const Frame Fl = relaunder(F); GAS unsigned char* const wsl = Fl.ws; GAS unsigned char* const wll = wsl + WS_W + (size_t)L * LW_BYTES; pg8::Gemm g{(const pg8::bf16_t*)(wsl + WS_XB), (const pg8::bf16_t*)(wll + LW_WIN), M, ZP, DM}; pg8::StaticOrder S; S.init(M, ZP, Fl.G, Fl.bx);
            EpiZ E{(GAS bf16*)(wsl + WS_RZ), (const GAS float*)(wsl + WS_RSSPX)};
            pg8::gemm_phase<EpiZ, pg8::StaticOrder, true, true>(F.lds, g, S, E, Fl.tid);
        }
        SEAM(p0 + 0);
        if (PHM(2) && IN(p0 + 1)) { const Frame Fl = relaunder(F); phase_index(Fl); }
        if (PHM(2) && IN(p0 + 1)) { const Frame Fl = relaunder(F); phase_prep(Fl, L); }
        SEAM(p0 + 1);
        if (PHM(3) && IN(p0 + 2)) { const Frame Fl = relaunder(F); phase_attn(Fl); }
        SEAM(p0 + 2);
        if (PHM(4) && IN(p0 + 3)) {
            const Frame Fl = relaunder(F); GAS unsigned char* const wsl = Fl.ws; GAS unsigned char* const wll = wsl + WS_W + (size_t)L * LW_BYTES; pg8::Gemm g{(const pg8::bf16_t*)(wsl + WS_RM), (const pg8::bf16_t*)(wll + LW_WOUT), M, DM, DM}; pg8::StaticOrder S; S.init(M, DM, Fl.G, Fl.bx);
            EpiT E{(GAS bf16*)(wsl + WS_RZ), (GAS float*)(wsl + WS_RSSPT)};
            pg8::gemm_phase<EpiT, pg8::StaticOrder, true, true>(F.lds, g, S, E, Fl.tid);
        }
        SEAM(p0 + 3);
        if (PHM(5) && IN(p0 + 4)) { const Frame Fl = relaunder(F); phase_resid(Fl, (const GAS bf16*)(Fl.ws + WS_RZ), (const GAS float*)(Fl.ws + WS_RSSPT), INP(Fl, IN_GMIXPOST) + L * DM); }
        SEAM(p0 + 4);
        if (PHM(6) && IN(p0 + 5)) {
            const Frame Fl = relaunder(F); GAS unsigned char* const wsl = Fl.ws; GAS unsigned char* const wll = wsl + WS_W + (size_t)L * LW_BYTES; pg8::Gemm g{(const pg8::bf16_t*)(wsl + WS_XB), (const pg8::bf16_t*)(wll + LW_WGU), M, 2 * DFF, DM}; pg8::StaticOrder S; S.init(M, 2 * DFF, Fl.G, Fl.bx);
            EpiSwiGLU E{(GAS bf16*)(wsl + WS_RZ), (const GAS float*)(wsl + WS_RSS1)};
            pg8::gemm_phase<EpiSwiGLU, pg8::StaticOrder, true, true>(F.lds, g, S, E, Fl.tid);
        }
        SEAM(p0 + 5);
        if (PHM(7) && IN(p0 + 6)) {
            { const Frame Fl = relaunder(F); GAS unsigned char* const wsl = Fl.ws; GAS unsigned char* const wll = wsl + WS_W + (size_t)L * LW_BYTES; pg8::Gemm g{(const pg8::bf16_t*)(wsl + WS_RZ), (const pg8::bf16_t*)(wll + LW_WD), M, DM, DFF}; pg8::StaticOrder S; S.init(M, DM, Fl.G, Fl.bx);
              EpiT E{(GAS bf16*)(wsl + WS_RM), (GAS float*)(wsl + WS_RSSPT)};
              pg8::gemm_phase<EpiT, pg8::StaticOrder, true, true>(F.lds, g, S, E, Fl.tid); }
            __syncthreads();
            { const Frame Fl = relaunder(F); GAS unsigned char* const wsl = Fl.ws; GAS unsigned char* const wll = wsl + WS_W + (size_t)L * LW_BYTES; pg8::Gemm g{(const pg8::bf16_t*)(wsl + WS_PB) + (size_t)L * M * PLE, (const pg8::bf16_t*)(wll + LW_WP), M, DM, PLE}; pg8::StaticOrder S; S.init(M, DM, Fl.G, Fl.bx);
              EpiB E{(GAS bf16*)(wsl + WS_RV)};
              pg8::gemm_phase<EpiB, pg8::StaticOrder, true, true>(F.lds, g, S, E, Fl.tid); }
        }
        SEAM(p0 + 6);
        if (PHM(8) && IN(p0 + 7)) { const Frame Fl = relaunder(F); phase_resid(Fl, (const GAS bf16*)(Fl.ws + WS_RM), (const GAS float*)(Fl.ws + WS_RSSPT), INP(Fl, IN_GFFNPOST) + L * DM); }
        SEAM(p0 + 7);
        if (PHM(9) && IN(p0 + 8)) {
            const Frame Fl = relaunder(F); GAS unsigned char* const wsl = Fl.ws; GAS unsigned char* const wll = wsl + WS_W + (size_t)L * LW_BYTES; pg8::Gemm g{(const pg8::bf16_t*)(wsl + WS_XB), (const pg8::bf16_t*)(wll + LW_WG), M, DM, DM}; pg8::StaticOrder S; S.init(M, DM, Fl.G, Fl.bx);
            EpiPLE E{Fl.X, (GAS bf16*)(wsl + WS_XB), (const GAS bf16*)(wsl + WS_RV), (const GAS float*)(wsl + WS_RSS1), (GAS float*)(wsl + WS_RSSPX)};
            pg8::gemm_phase<EpiPLE, pg8::StaticOrder, true, true>(F.lds, g, S, E, Fl.tid);
        }
        SEAM(p0 + 8);
    }
        }

    { constexpr int L = 1;
    {
        const int p0 = 1 + 9 * L;
        GAS unsigned char* wl = ws + WS_W + (size_t)L * LW_BYTES;
        if (PHM(1) && IN(p0 + 0)) {
            const Frame Fl = relaunder(F); GAS unsigned char* const wsl = Fl.ws; GAS unsigned char* const wll = wsl + WS_W + (size_t)L * LW_BYTES; pg8::Gemm g{(const pg8::bf16_t*)(wsl + WS_XB), (const pg8::bf16_t*)(wll + LW_WIN), M, ZP, DM}; pg8::StaticOrder S; S.init(M, ZP, Fl.G, Fl.bx);
            EpiZ E{(GAS bf16*)(wsl + WS_RZ), (const GAS float*)(wsl + WS_RSSPX)};
            pg8::gemm_phase<EpiZ, pg8::StaticOrder, true, true>(F.lds, g, S, E, Fl.tid);
        }
        SEAM(p0 + 0);
        if (PHM(2) && IN(p0 + 1)) { const Frame Fl = relaunder(F); phase_index(Fl); }
        if (PHM(2) && IN(p0 + 1)) { const Frame Fl = relaunder(F); phase_prep(Fl, L); }
        SEAM(p0 + 1);
        if (PHM(3) && IN(p0 + 2)) { const Frame Fl = relaunder(F); phase_attn(Fl); }
        SEAM(p0 + 2);
        if (PHM(4) && IN(p0 + 3)) {
            const Frame Fl = relaunder(F); GAS unsigned char* const wsl = Fl.ws; GAS unsigned char* const wll = wsl + WS_W + (size_t)L * LW_BYTES; pg8::Gemm g{(const pg8::bf16_t*)(wsl + WS_RM), (const pg8::bf16_t*)(wll + LW_WOUT), M, DM, DM}; pg8::StaticOrder S; S.init(M, DM, Fl.G, Fl.bx);
            EpiT E{(GAS bf16*)(wsl + WS_RZ), (GAS float*)(wsl + WS_RSSPT)};
            pg8::gemm_phase<EpiT, pg8::StaticOrder, true, true>(F.lds, g, S, E, Fl.tid);
        }
        SEAM(p0 + 3);
        if (PHM(5) && IN(p0 + 4)) { const Frame Fl = relaunder(F); phase_resid(Fl, (const GAS bf16*)(Fl.ws + WS_RZ), (const GAS float*)(Fl.ws + WS_RSSPT), INP(Fl, IN_GMIXPOST) + L * DM); }
        SEAM(p0 + 4);
        if (PHM(6) && IN(p0 + 5)) {
            const Frame Fl = relaunder(F); GAS unsigned char* const wsl = Fl.ws; GAS unsigned char* const wll = wsl + WS_W + (size_t)L * LW_BYTES; pg8::Gemm g{(const pg8::bf16_t*)(wsl + WS_XB), (const pg8::bf16_t*)(wll + LW_WGU), M, 2 * DFF, DM}; pg8::StaticOrder S; S.init(M, 2 * DFF, Fl.G, Fl.bx);
            EpiSwiGLU E{(GAS bf16*)(wsl + WS_RZ), (const GAS float*)(wsl + WS_RSS1)};
            pg8::gemm_phase<EpiSwiGLU, pg8::StaticOrder, true, true>(F.lds, g, S, E, Fl.tid);
        }
        SEAM(p0 + 5);
        if (PHM(7) && IN(p0 + 6)) {
            { const Frame Fl = relaunder(F); GAS unsigned char* const wsl = Fl.ws; GAS unsigned char* const wll = wsl + WS_W + (size_t)L * LW_BYTES; pg8::Gemm g{(const pg8::bf16_t*)(wsl + WS_RZ), (const pg8::bf16_t*)(wll + LW_WD), M, DM, DFF}; pg8::StaticOrder S; S.init(M, DM, Fl.G, Fl.bx);
              EpiT E{(GAS bf16*)(wsl + WS_RM), (GAS float*)(wsl + WS_RSSPT)};
              pg8::gemm_phase<EpiT, pg8::StaticOrder, true, true>(F.lds, g, S, E, Fl.tid); }
            __syncthreads();
            { const Frame Fl = relaunder(F); GAS unsigned char* const wsl = Fl.ws; GAS unsigned char* const wll = wsl + WS_W + (size_t)L * LW_BYTES; pg8::Gemm g{(const pg8::bf16_t*)(wsl + WS_PB) + (size_t)L * M * PLE, (const pg8::bf16_t*)(wll + LW_WP), M, DM, PLE}; pg8::StaticOrder S; S.init(M, DM, Fl.G, Fl.bx);
              EpiB E{(GAS bf16*)(wsl + WS_RV)};
              pg8::gemm_phase<EpiB, pg8::StaticOrder, true, true>(F.lds, g, S, E, Fl.tid); }
        }
        SEAM(p0 + 6);
        if (PHM(8) && IN(p0 + 7)) { const Frame Fl = relaunder(F); phase_resid(Fl, (const GAS bf16*)(Fl.ws + WS_RM), (const GAS float*)(Fl.ws + WS_RSSPT), INP(Fl, IN_GFFNPOST) + L * DM); }
        SEAM(p0 + 7);
        if (PHM(9) && IN(p0 + 8)) {
            const Frame Fl = relaunder(F); GAS unsigned char* const wsl = Fl.ws; GAS unsigned char* const wll = wsl + WS_W + (size_t)L * LW_BYTES; pg8::Gemm g{(const pg8::bf16_t*)(wsl + WS_XB), (const pg8::bf16_t*)(wll + LW_WG), M, DM, DM}; pg8::StaticOrder S; S.init(M, DM, Fl.G, Fl.bx);
            EpiPLE E{Fl.X, (GAS bf16*)(wsl + WS_XB), (const GAS bf16*)(wsl + WS_RV), (const GAS float*)(wsl + WS_RSS1), (GAS float*)(wsl + WS_RSSPX)};
            pg8::gemm_phase<EpiPLE, pg8::StaticOrder, true, true>(F.lds, g, S, E, Fl.tid);
        }
        SEAM(p0 + 8);
    }
        }

    { constexpr int L = 2;
    {
        const int p0 = 1 + 9 * L;
        GAS unsigned char* wl = ws + WS_W + (size_t)L * LW_BYTES;
        if (PHM(1) && IN(p0 + 0)) {
            const Frame Fl = relaunder(F); GAS unsigned char* const wsl = Fl.ws; GAS unsigned char* const wll = wsl + WS_W + (size_t)L * LW_BYTES; pg8::Gemm g{(const pg8::bf16_t*)(wsl + WS_XB), (const pg8::bf16_t*)(wll + LW_WIN), M, ZP, DM}; pg8::StaticOrder S; S.init(M, ZP, Fl.G, Fl.bx);
            EpiZ E{(GAS bf16*)(wsl + WS_RZ), (const GAS float*)(wsl + WS_RSSPX)};
            pg8::gemm_phase<EpiZ, pg8::StaticOrder, true, true>(F.lds, g, S, E, Fl.tid);
        }
        SEAM(p0 + 0);
        if (PHM(2) && IN(p0 + 1)) { const Frame Fl = relaunder(F); phase_index(Fl); }
        if (PHM(2) && IN(p0 + 1)) { const Frame Fl = relaunder(F); phase_prep(Fl, L); }
        SEAM(p0 + 1);
        if (PHM(3) && IN(p0 + 2)) { const Frame Fl = relaunder(F); phase_attn(Fl); }
        SEAM(p0 + 2);
        if (PHM(4) && IN(p0 + 3)) {
            const Frame Fl = relaunder(F); GAS unsigned char* const wsl = Fl.ws; GAS unsigned char* const wll = wsl + WS_W + (size_t)L * LW_BYTES; pg8::Gemm g{(const pg8::bf16_t*)(wsl + WS_RM), (const pg8::bf16_t*)(wll + LW_WOUT), M, DM, DM}; pg8::StaticOrder S; S.init(M, DM, Fl.G, Fl.bx);
            EpiT E{(GAS bf16*)(wsl + WS_RZ), (GAS float*)(wsl + WS_RSSPT)};
            pg8::gemm_phase<EpiT, pg8::StaticOrder, true, true>(F.lds, g, S, E, Fl.tid);
        }
        SEAM(p0 + 3);
        if (PHM(5) && IN(p0 + 4)) { const Frame Fl = relaunder(F); phase_resid(Fl, (const GAS bf16*)(Fl.ws + WS_RZ), (const GAS float*)(Fl.ws + WS_RSSPT), INP(Fl, IN_GMIXPOST) + L * DM); }
        SEAM(p0 + 4);
        if (PHM(6) && IN(p0 + 5)) {
            const Frame Fl = relaunder(F); GAS unsigned char* const wsl = Fl.ws; GAS unsigned char* const wll = wsl + WS_W + (size_t)L * LW_BYTES; pg8::Gemm g{(const pg8::bf16_t*)(wsl + WS_XB), (const pg8::bf16_t*)(wll + LW_WGU), M, 2 * DFF, DM}; pg8::StaticOrder S; S.init(M, 2 * DFF, Fl.G, Fl.bx);
            EpiSwiGLU E{(GAS bf16*)(wsl + WS_RZ), (const GAS float*)(wsl + WS_RSS1)};
            pg8::gemm_phase<EpiSwiGLU, pg8::StaticOrder, true, true>(F.lds, g, S, E, Fl.tid);
        }
        SEAM(p0 + 5);
        if (PHM(7) && IN(p0 + 6)) {
            { const Frame Fl = relaunder(F); GAS unsigned char* const wsl = Fl.ws; GAS unsigned char* const wll = wsl + WS_W + (size_t)L * LW_BYTES; pg8::Gemm g{(const pg8::bf16_t*)(wsl + WS_RZ), (const pg8::bf16_t*)(wll + LW_WD), M, DM, DFF}; pg8::StaticOrder S; S.init(M, DM, Fl.G, Fl.bx);
              EpiT E{(GAS bf16*)(wsl + WS_RM), (GAS float*)(wsl + WS_RSSPT)};
              pg8::gemm_phase<EpiT, pg8::StaticOrder, true, true>(F.lds, g, S, E, Fl.tid); }
            __syncthreads();
            { const Frame Fl = relaunder(F); GAS unsigned char* const wsl = Fl.ws; GAS unsigned char* const wll = wsl + WS_W + (size_t)L * LW_BYTES; pg8::Gemm g{(const pg8::bf16_t*)(wsl + WS_PB) + (size_t)L * M * PLE, (const pg8::bf16_t*)(wll + LW_WP), M, DM, PLE}; pg8::StaticOrder S; S.init(M, DM, Fl.G, Fl.bx);
              EpiB E{(GAS bf16*)(wsl + WS_RV)};
              pg8::gemm_phase<EpiB, pg8::StaticOrder, true, true>(F.lds, g, S, E, Fl.tid); }
        }
        SEAM(p0 + 6);
        if (PHM(8) && IN(p0 + 7)) { const Frame Fl = relaunder(F); phase_resid(Fl, (const GAS bf16*)(Fl.ws + WS_RM), (const GAS float*)(Fl.ws + WS_RSSPT), INP(Fl, IN_GFFNPOST) + L * DM); }
        SEAM(p0 + 7);
        if (PHM(9) && IN(p0 + 8)) {
            const Frame Fl = relaunder(F); GAS unsigned char* const wsl = Fl.ws; GAS unsigned char* const wll = wsl + WS_W + (size_t)L * LW_BYTES; pg8::Gemm g{(const pg8::bf16_t*)(wsl + WS_XB), (const pg8::bf16_t*)(wll + LW_WG), M, DM, DM}; pg8::StaticOrder S; S.init(M, DM, Fl.G, Fl.bx);
            EpiPLE E{Fl.X, (GAS bf16*)(wsl + WS_XB), (const GAS bf16*)(wsl + WS_RV), (const GAS float*)(wsl + WS_RSS1), (GAS float*)(wsl + WS_RSSPX)};
            pg8::gemm_phase<EpiPLE, pg8::StaticOrder, true, true>(F.lds, g, S, E, Fl.tid);
        }
        SEAM(p0 + 8);
    }
        }

    { constexpr int L = 3;
    {
        const int p0 = 1 + 9 * L;
        GAS unsigned char* wl = ws + WS_W + (size_t)L * LW_BYTES;
        if (PHM(1) && IN(p0 + 0)) {
            const Frame Fl = relaunder(F); GAS unsigned char* const wsl = Fl.ws; GAS unsigned char* const wll = wsl + WS_W + (size_t)L * LW_BYTES; pg8::Gemm g{(const pg8::bf16_t*)(wsl + WS_XB), (const pg8::bf16_t*)(wll + LW_WIN), M, ZP, DM}; pg8::StaticOrder S; S.init(M, ZP, Fl.G, Fl.bx);
            EpiZ E{(GAS bf16*)(wsl + WS_RZ), (const GAS float*)(wsl + WS_RSSPX)};
            pg8::gemm_phase<EpiZ, pg8::StaticOrder, true, true>(F.lds, g, S, E, Fl.tid);
        }
        SEAM(p0 + 0);
        if (PHM(2) && IN(p0 + 1)) { const Frame Fl = relaunder(F); phase_index(Fl); }
        if (PHM(2) && IN(p0 + 1)) { const Frame Fl = relaunder(F); phase_prep(Fl, L); }
        SEAM(p0 + 1);
        if (PHM(3) && IN(p0 + 2)) { const Frame Fl = relaunder(F); phase_attn(Fl); }
        SEAM(p0 + 2);
        if (PHM(4) && IN(p0 + 3)) {
            const Frame Fl = relaunder(F); GAS unsigned char* const wsl = Fl.ws; GAS unsigned char* const wll = wsl + WS_W + (size_t)L * LW_BYTES; pg8::Gemm g{(const pg8::bf16_t*)(wsl + WS_RM), (const pg8::bf16_t*)(wll + LW_WOUT), M, DM, DM}; pg8::StaticOrder S; S.init(M, DM, Fl.G, Fl.bx);
            EpiT E{(GAS bf16*)(wsl + WS_RZ), (GAS float*)(wsl + WS_RSSPT)};
            pg8::gemm_phase<EpiT, pg8::StaticOrder, true, true>(F.lds, g, S, E, Fl.tid);
        }
        SEAM(p0 + 3);
        if (PHM(5) && IN(p0 + 4)) { const Frame Fl = relaunder(F); phase_resid(Fl, (const GAS bf16*)(Fl.ws + WS_RZ), (const GAS float*)(Fl.ws + WS_RSSPT), INP(Fl, IN_GMIXPOST) + L * DM); }
        SEAM(p0 + 4);
        if (PHM(6) && IN(p0 + 5)) {
            const Frame Fl = relaunder(F); GAS unsigned char* const wsl = Fl.ws; GAS unsigned char* const wll = wsl + WS_W + (size_t)L * LW_BYTES; pg8::Gemm g{(const pg8::bf16_t*)(wsl + WS_XB), (const pg8::bf16_t*)(wll + LW_WGU), M, 2 * DFF, DM}; pg8::StaticOrder S; S.init(M, 2 * DFF, Fl.G, Fl.bx);
            EpiSwiGLU E{(GAS bf16*)(wsl + WS_RZ), (const GAS float*)(wsl + WS_RSS1)};
            pg8::gemm_phase<EpiSwiGLU, pg8::StaticOrder, true, true>(F.lds, g, S, E, Fl.tid);
        }
        SEAM(p0 + 5);
        if (PHM(7) && IN(p0 + 6)) {
            { const Frame Fl = relaunder(F); GAS unsigned char* const wsl = Fl.ws; GAS unsigned char* const wll = wsl + WS_W + (size_t)L * LW_BYTES; pg8::Gemm g{(const pg8::bf16_t*)(wsl + WS_RZ), (const pg8::bf16_t*)(wll + LW_WD), M, DM, DFF}; pg8::StaticOrder S; S.init(M, DM, Fl.G, Fl.bx);
              EpiT E{(GAS bf16*)(wsl + WS_RM), (GAS float*)(wsl + WS_RSSPT)};
              pg8::gemm_phase<EpiT, pg8::StaticOrder, true, true>(F.lds, g, S, E, Fl.tid); }
            __syncthreads();
            { const Frame Fl = relaunder(F); GAS unsigned char* const wsl = Fl.ws; GAS unsigned char* const wll = wsl + WS_W + (size_t)L * LW_BYTES; pg8::Gemm g{(const pg8::bf16_t*)(wsl + WS_PB) + (size_t)L * M * PLE, (const pg8::bf16_t*)(wll + LW_WP), M, DM, PLE}; pg8::StaticOrder S; S.init(M, DM, Fl.G, Fl.bx);
              EpiB E{(GAS bf16*)(wsl + WS_RV)};
              pg8::gemm_phase<EpiB, pg8::StaticOrder, true, true>(F.lds, g, S, E, Fl.tid); }
        }
        SEAM(p0 + 6);
        if (PHM(8) && IN(p0 + 7)) { const Frame Fl = relaunder(F); phase_resid(Fl, (const GAS bf16*)(Fl.ws + WS_RM), (const GAS float*)(Fl.ws + WS_RSSPT), INP(Fl, IN_GFFNPOST) + L * DM); }
        SEAM(p0 + 7);
        if (PHM(9) && IN(p0 + 8)) {
            const Frame Fl = relaunder(F); GAS unsigned char* const wsl = Fl.ws; GAS unsigned char* const wll = wsl + WS_W + (size_t)L * LW_BYTES; pg8::Gemm g{(const pg8::bf16_t*)(wsl + WS_XB), (const pg8::bf16_t*)(wll + LW_WG), M, DM, DM}; pg8::StaticOrder S; S.init(M, DM, Fl.G, Fl.bx);
            EpiPLE E{Fl.X, (GAS bf16*)(wsl + WS_XB), (const GAS bf16*)(wsl + WS_RV), (const GAS float*)(wsl + WS_RSS1), (GAS float*)(wsl + WS_RSSPX)};
            pg8::gemm_phase<EpiPLE, pg8::StaticOrder, true, true>(F.lds, g, S, E, Fl.tid);
        }
        SEAM(p0 + 8);
    }
        }

#undef IN
#undef SEAM
}

extern "C" void kernel_launch(void* const* d_in, const int* in_sizes, int n_in, void* d_out, int out_size, void* d_ws, size_t ws_size, hipStream_t stream) {
    static int grid = 0;
    if (grid == 0) {
        if (n_in != 17 || in_sizes[0] != M * DM || out_size != M * DM || ws_size < WS_END) {
            fprintf(stderr, "kernel_launch: unexpected problem (n_in %d, in0 %d, out %d, ws %zu < %zu); nothing launched\n", n_in, n_in > 0 ? in_sizes[0] : -1, out_size, ws_size, (size_t)WS_END); grid = -1; return; }
        int dev = 0, cus = 0, per_cu = 0;
        if (hipGetDevice(&dev) != hipSuccess || hipDeviceGetAttribute(&cus, hipDeviceAttributeMultiprocessorCount, dev) != hipSuccess) { grid = -1; return; }
        if (hipFuncSetAttribute((const void*)fwd, hipFuncAttributeMaxDynamicSharedMemorySize, LDS_BYTES) != hipSuccess) { fprintf(stderr, "kernel_launch: hipFuncSetAttribute failed\n"); grid = -1; return; }
        if (hipOccupancyMaxActiveBlocksPerMultiprocessor(&per_cu, (const void*)fwd, NTHREADS, LDS_BYTES) != hipSuccess || per_cu < 1)
            fprintf(stderr, "kernel_launch: occupancy query reports %d workgroups per CU\n", per_cu);
        (void)hipGetLastError();
        grid = cus;
    }
    if (grid < 0) return;
    if (hipMemsetAsync((char*)d_ws + WS_CTL, 0, CTL_ZERO_BYTES, stream) != hipSuccess) return;
    Args a{};
    for (int i = 0; i < 17; ++i) a.in[i] = (const float*)d_in[i];
    a.out = (float*)d_out; a.ws = (unsigned char*)d_ws;
#if MK_ONE_LAUNCH
    a.ph_lo = 0; a.ph_hi = NPHASES;
    hipLaunchKernelGGL(fwd, dim3(grid), dim3(NTHREADS), LDS_BYTES, stream, a);
#else
    for (int p = 0; p < NPHASES; ++p) { a.ph_lo = p; a.ph_hi = p + 1; hipLaunchKernelGGL(fwd, dim3(grid), dim3(NTHREADS), LDS_BYTES, stream, a); }
#endif
}
```

```cpp
#include <hip/hip_runtime.h>
#include <cstdio>
#include <cstdint>
namespace pg8 {
#define PG8_LAS __attribute__((address_space(3)))
typedef unsigned short bf16_t;
typedef short bf16x8 __attribute__((ext_vector_type(8)));
typedef float f32x4 __attribute__((ext_vector_type(4)));
typedef unsigned u32x4 __attribute__((ext_vector_type(4)));
constexpr int BM = 256, BK = 64, HALF = 128, HTB = HALF * BK * 2  , STAGE_BYTES = 8 * HTB, NXCD = 8, WGM = 8;

__host__ __device__ __forceinline__ int lds_byte(int r, int c) { const int st = (r >> 4) * 2 + (c >> 5), rr = r & 15, cc = c & 31, ob = rr * 64 + cc * 2; return st * 1024 + (ob ^ (((ob >> 9) & 1) << 5)); }
__host__ __device__ __forceinline__ void stage_rc(int b, int& R, int& C) { const int st = b / 1024, sb = b % 1024, swz = sb ^ (((sb >> 9) & 1) << 5); R = (st >> 1) * 16 + swz / 64; C = (st & 1) * 32 + (swz % 64) / 2; }
__host__ __device__ __forceinline__ int perm32(int rho) { const int n = rho >> 4, i = rho & 15; return 8 * (i >> 2) + 4 * n + (i & 3); }

struct Unit { int pm, pn; };
struct Gemm { const bf16_t* A; const bf16_t* Bt; int M, N, K; };

struct StaticOrder {
    int nM, nN, nwg, G, c;
    __host__ __device__ void init(int M, int N, int G_, int c_) { nM = M / BM; nN = N / BM; nwg = nM * nN; G = G_; c = c_; }
    __host__ __device__ bool next(int i, Unit& u) const {
        const long L = (long)i * G + c; if (L >= nwg) return false;
        int wgid = (int)L; { const int q = nwg / NXCD, r = nwg % NXCD, xcd = wgid % NXCD, off = wgid / NXCD; wgid = (xcd < r ? xcd * (q + 1) : r * (q + 1) + (xcd - r) * q) + off; }
        const int nig = WGM * nN, gid = wgid / nig, fm = gid * WGM, gsz = (nM - fm) < WGM ? (nM - fm) : WGM;
        u.pm = fm + ((wgid % nig) % gsz); u.pn = (wgid % nig) / gsz; return true;
    }
    __device__ __forceinline__ void a_ready(const Unit&) const {}
    __device__ __forceinline__ void done(const Unit&) const {}
};

template <class Epi, class Sched, bool ALIGN_EPI = false, bool SP2 = false>
__device__ __forceinline__ void gemm_phase(PG8_LAS unsigned char* lds, const Gemm g, const Sched& S, const Epi& E, int tid_in) {
    int tid_l = tid_in; asm volatile("" : "+v"(tid_l)); const int tid = tid_l, wid = __builtin_amdgcn_readfirstlane(tid >> 6), lane = tid & 63, wr = wid >> 2, wc = wid & 3, fr = lane & 15, fq = lane >> 4;
    const int K = g.K, nt = K / BK;
    unsigned voffA[2], voffB[2];
#pragma unroll
    for (int i = 0; i < 2; ++i) { int R, C; stage_rc(tid * 16 + i * 8192, R, C); const int Rb = Epi::PERM ? ((R & ~31) + perm32(R & 31)) : R;
        voffA[i] = (unsigned)(R * K + C) * 2u; voffB[i] = (unsigned)(Rb * K + C) * 2u; }
    const size_t kstep = (size_t)(BK * 2);
    const size_t hstep = (size_t)HALF * K * 2;
    const size_t tstep = 2 * hstep;
    const unsigned ldsw = (unsigned)wid * 1024u;
    const int aoff = lds_byte(wr * 64 + fr, fq * 8), boff = lds_byte(wc * 32 + fr, fq * 8);
#define PG8_SA(b, h) (((b) * 2 + (h)) * HTB)
#define PG8_SB(b, h) ((4 + (b) * 2 + (h)) * HTB)
#define PG8_STAGE(bufoff, gbase, voff) do { _Pragma("unroll") for (int _i = 0; _i < 2; ++_i) \
        __builtin_amdgcn_global_load_lds((const unsigned*)((const char*)(gbase) + (voff)[_i]), (PG8_LAS unsigned*)(lds + (bufoff) + ldsw + _i * 8192), 16, 0, 0); } while (0)
#define PG8_LDA(dst, b, h) do { _Pragma("unroll") for (int m = 0; m < 4; ++m) _Pragma("unroll") for (int k = 0; k < 2; ++k) dst[m][k] = *(const PG8_LAS bf16x8*)(lds + PG8_SA(b, h) + aoff + m * 2048 + k * 1024); } while (0)
#define PG8_LDB(dst, b, h) do { _Pragma("unroll") for (int n = 0; n < 2; ++n) _Pragma("unroll") for (int k = 0; k < 2; ++k) dst[n][k] = *(const PG8_LAS bf16x8*)(lds + PG8_SB(b, h) + boff + n * 2048 + k * 1024); } while (0)
#define PG8_MMA(ai, bj, At, Bt) do { __builtin_amdgcn_s_setprio(1); _Pragma("unroll") for (int m = 0; m < 4; ++m) _Pragma("unroll") for (int n = 0; n < 2; ++n) _Pragma("unroll") for (int k = 0; k < 2; ++k) \
        acc[ai][bj][m][n] = __builtin_amdgcn_mfma_f32_16x16x32_bf16(Bt[n][k], At[m][k], acc[ai][bj][m][n], 0, 0, 0); __builtin_amdgcn_s_setprio(0); } while (0)
#define PG8_WAIT_V(n) asm volatile("s_waitcnt vmcnt(" #n ")" ::: "memory")
#define PG8_WAIT_L(n) asm volatile("s_waitcnt lgkmcnt(" #n ")" ::: "memory")
#define PG8_BAR __builtin_amdgcn_s_barrier()
#define PG8_SCHED __builtin_amdgcn_sched_barrier(0)
    Unit cur, nxt; int ui = 0;
    if (!S.next(0, cur)) return;
    f32x4 acc[2][2][4][2];
    bf16x8 At[4][2], B0[2][2], B1[2][2];
    const char* cA = (const char*)g.A + (size_t)cur.pm * tstep; const char* cB = (const char*)g.Bt + (size_t)cur.pn * tstep;
    S.a_ready(cur);
    if constexpr (SP2) {
        PG8_STAGE(PG8_SB(0, 0), cB, voffB); PG8_STAGE(PG8_SB(0, 1), cB + hstep, voffB); PG8_STAGE(PG8_SA(0, 0), cA, voffA); PG8_STAGE(PG8_SA(0, 1), cA + hstep, voffA);
        if (wr == 1) PG8_BAR;
        PG8_WAIT_V(2); PG8_BAR;
        PG8_STAGE(PG8_SB(1, 0), cB + kstep, voffB); PG8_STAGE(PG8_SA(1, 0), cA + kstep, voffA); PG8_STAGE(PG8_SB(1, 1), cB + hstep + kstep, voffB);
        PG8_WAIT_V(6); PG8_BAR;
    } else {
        PG8_STAGE(PG8_SB(0, 0), cB, voffB); PG8_STAGE(PG8_SA(0, 0), cA, voffA); PG8_STAGE(PG8_SB(0, 1), cB + hstep, voffB); PG8_STAGE(PG8_SA(0, 1), cA + hstep, voffA);
        if (wr == 1) PG8_BAR;
        PG8_WAIT_V(4); PG8_BAR;
        PG8_STAGE(PG8_SB(1, 0), cB + kstep, voffB); PG8_STAGE(PG8_SA(1, 0), cA + kstep, voffA); PG8_STAGE(PG8_SB(1, 1), cB + hstep + kstep, voffB);
        PG8_WAIT_V(6); PG8_BAR;
    }
    asm volatile("" ::: "memory");
#pragma unroll
    for (int a = 0; a < 2; ++a)
#pragma unroll
        for (int b = 0; b < 2; ++b)
#pragma unroll
            for (int m = 0; m < 4; ++m)
#pragma unroll
                for (int n = 0; n < 2; ++n) acc[a][b][m][n] = (f32x4){0.f, 0.f, 0.f, 0.f};
    for (;;) {
        const bool has_next = S.next(ui + 1, nxt);
        const char* nA = has_next ? (const char*)g.A + (size_t)nxt.pm * tstep : cA; const char* nB = has_next ? (const char*)g.Bt + (size_t)nxt.pn * tstep : cB;
        for (int t = 0; t < nt; t += 2) {
            const bool last = (t == nt - 2);
            const char* a1 = cA + (size_t)(t + 1) * kstep;
            const char* a2 = last ? nA : cA + (size_t)(t + 2) * kstep; const char* b2 = last ? nB : cB + (size_t)(t + 2) * kstep;
            const char* a3 = a2 + kstep; const char* b3 = b2 + kstep;
            if (last && has_next) S.a_ready(nxt);
            if constexpr (SP2) {
            PG8_LDB(B0, 0, 0); PG8_LDB(B1, 0, 1); PG8_SCHED; PG8_LDA(At, 0, 0); PG8_STAGE(PG8_SA(1, 1), a1 + hstep, voffA);
            PG8_WAIT_V(8); PG8_WAIT_L(0); PG8_BAR; PG8_MMA(0, 0, At, B0); PG8_MMA(0, 1, At, B1); PG8_BAR; PG8_SCHED;
            PG8_LDA(At, 0, 1); PG8_STAGE(PG8_SB(0, 0), b2, voffB); PG8_STAGE(PG8_SB(0, 1), b2 + hstep, voffB); PG8_STAGE(PG8_SA(0, 0), a2, voffA);
            PG8_WAIT_V(8); PG8_WAIT_L(0); PG8_BAR; PG8_MMA(1, 0, At, B0); PG8_MMA(1, 1, At, B1); PG8_BAR; PG8_SCHED;
            PG8_LDB(B0, 1, 0); PG8_LDB(B1, 1, 1); PG8_SCHED; PG8_LDA(At, 1, 0); PG8_STAGE(PG8_SA(0, 1), a2 + hstep, voffA);
            PG8_WAIT_V(8); PG8_WAIT_L(0); PG8_BAR; PG8_MMA(0, 0, At, B0); PG8_MMA(0, 1, At, B1); PG8_BAR; PG8_SCHED;
            PG8_LDA(At, 1, 1); PG8_STAGE(PG8_SB(1, 0), b3, voffB); PG8_STAGE(PG8_SB(1, 1), b3 + hstep, voffB); PG8_STAGE(PG8_SA(1, 0), a3, voffA);
            PG8_WAIT_V(8); PG8_WAIT_L(0); PG8_BAR; PG8_MMA(1, 0, At, B0); PG8_MMA(1, 1, At, B1); PG8_BAR; PG8_SCHED;
            } else {
            PG8_LDB(B0, 0, 0); PG8_SCHED; PG8_LDA(At, 0, 0); PG8_STAGE(PG8_SA(1, 1), a1 + hstep, voffA);
            PG8_WAIT_L(8); PG8_BAR; PG8_WAIT_L(0); PG8_MMA(0, 0, At, B0); PG8_BAR; PG8_SCHED;
            PG8_LDB(B1, 0, 1); PG8_STAGE(PG8_SB(0, 0), b2, voffB);
            PG8_BAR; PG8_WAIT_L(0); PG8_MMA(0, 1, At, B1); PG8_BAR;
            PG8_LDA(At, 0, 1); PG8_STAGE(PG8_SA(0, 0), a2, voffA);
            PG8_BAR; PG8_WAIT_L(0); PG8_MMA(1, 0, At, B0); PG8_BAR; PG8_SCHED;
            PG8_STAGE(PG8_SB(0, 1), b2 + hstep, voffB);
            PG8_WAIT_V(6); PG8_BAR; PG8_MMA(1, 1, At, B1); PG8_BAR;
            PG8_LDB(B0, 1, 0); PG8_SCHED; PG8_LDA(At, 1, 0); PG8_STAGE(PG8_SA(0, 1), a2 + hstep, voffA);
            PG8_WAIT_L(8); PG8_BAR; PG8_WAIT_L(0); PG8_MMA(0, 0, At, B0); PG8_BAR; PG8_SCHED;
            PG8_LDB(B1, 1, 1); PG8_STAGE(PG8_SB(1, 0), b3, voffB);
            PG8_BAR; PG8_WAIT_L(0); PG8_MMA(0, 1, At, B1); PG8_BAR;
            PG8_LDA(At, 1, 1); PG8_STAGE(PG8_SA(1, 0), a3, voffA);
            PG8_BAR; PG8_WAIT_L(0); PG8_MMA(1, 0, At, B0); PG8_BAR; PG8_SCHED;
            PG8_STAGE(PG8_SB(1, 1), b3 + hstep, voffB);
            PG8_WAIT_V(6); PG8_BAR; PG8_MMA(1, 1, At, B1); PG8_BAR;
            }
        }
        if constexpr (ALIGN_EPI) { if (wr == 0) PG8_BAR; }
        if constexpr (!Epi::AFTER_DRAIN) { int ln_; asm volatile("v_mbcnt_lo_u32_b32 %0, -1, 0\n\tv_mbcnt_hi_u32_b32 %0, -1, %0" : "=v"(ln_)); E(acc, cur, wr, wc, ln_ & 15, ln_ >> 4); S.done(cur); }
        if (!has_next) break;
#pragma unroll
        for (int a = 0; a < 2; ++a)
#pragma unroll
            for (int b = 0; b < 2; ++b)
#pragma unroll
                for (int m = 0; m < 4; ++m)
#pragma unroll
                    for (int n = 0; n < 2; ++n) acc[a][b][m][n] = (f32x4){0.f, 0.f, 0.f, 0.f};
        cur = nxt; cA = nA; cB = nB; ++ui;
        if constexpr (ALIGN_EPI) { if (wr == 1) PG8_BAR; }
    }
    PG8_WAIT_V(0);
    if constexpr (!ALIGN_EPI) { if (wr == 0) PG8_BAR; }
    PG8_BAR;
    if constexpr (Epi::AFTER_DRAIN) { E.fused(acc, cur, wr, wc, fr, fq, lds, wid, lane); S.done(cur); }
#undef PG8_SA
#undef PG8_SB
#undef PG8_STAGE
#undef PG8_LDA
#undef PG8_LDB
#undef PG8_MMA
#undef PG8_WAIT_V
#undef PG8_WAIT_L
#undef PG8_BAR
#undef PG8_SCHED
}
}

constexpr int NB = 4, SEQ = 4096, DM = 1024, DEPTH = 4;
constexpr int M = NB * SEQ;
constexpr int ZP = 3328;
constexpr int NIN = 3144;
constexpr int DFF = 2816, PLE = 256;
constexpr float RMS_EPS = 1e-6f;
constexpr float LOG2E = 1.4426950408889634f;
constexpr float C2 = 0.125f * LOG2E;
constexpr int ZC_AIN = 0, ZC_AC = 256, ZC_AB = 512, ZC_PV = 768, ZC_Q = 1024  , ZC_K = 1536, ZC_V = 2048, ZC_IQ = 2560, ZC_IK = 3072, ZC_IW = 3136;

constexpr size_t MiB = 1u << 20;
constexpr size_t WS_CTL = 0, CTL_ZERO_BYTES = 64 * 1024;
constexpr size_t WS_RSSPX = 1 * MiB;
constexpr size_t WS_RSS1 = 2 * MiB;
constexpr size_t WS_RSSPT = 3 * MiB;
constexpr size_t WS_KM = 4 * MiB;
constexpr size_t WS_W = 8 * MiB;
constexpr size_t LW_WIN = 0, LW_WOUT = LW_WIN + (size_t)ZP * DM * 2, LW_WGU = LW_WOUT + (size_t)DM * DM * 2, LW_WD = LW_WGU + (size_t)2 * DFF * DM * 2,
                 LW_WG = LW_WD + (size_t)DM * DFF * 2, LW_WP = LW_WG + (size_t)DM * DM * 2, LW_BYTES = LW_WP + (size_t)DM * PLE * 2;
static_assert(LW_BYTES == 27 * MiB + MiB / 2, "per-layer weight block");
constexpr size_t WS_PB = WS_W + DEPTH * LW_BYTES;
constexpr size_t WS_XB = WS_PB + (size_t)DEPTH * M * PLE * 2;
constexpr size_t WS_RZ = WS_XB + (size_t)M * DM * 2;
constexpr size_t WS_RM = WS_RZ + (size_t)M * ZP * 2;
constexpr size_t WS_RV = WS_RM + (size_t)M * DM * 2;
constexpr size_t WS_VT = WS_RV, WS_DMASK = WS_RV + 16 * MiB;
constexpr size_t WS_END = WS_RV + 32 * MiB;
static_assert(WS_END == 350 * MiB, "workspace map");

constexpr int RING_BYTES = 131072;
constexpr int IDX_MROW_OFF = 131072;
constexpr int MISC_OFF = 143360;
constexpr int LDS_BYTES = 147456;
constexpr int NWAVES = 8, NTHREADS = 512;

#define LAS __attribute__((address_space(3)))
#define GAS __attribute__((address_space(1)))
typedef unsigned short bf16;
typedef unsigned v4u __attribute__((ext_vector_type(4)));
typedef unsigned v2u __attribute__((ext_vector_type(2)));
typedef float f32x4 __attribute__((ext_vector_type(4)));
typedef float f32x16 __attribute__((ext_vector_type(16)));
typedef short bf16x8 __attribute__((ext_vector_type(8)));
typedef short s16x4 __attribute__((ext_vector_type(4)));
typedef unsigned long long u64;
#define LDS_WAIT() asm volatile("s_waitcnt lgkmcnt(0)" ::: "memory")
#define VM_WAIT() asm volatile("s_waitcnt vmcnt(0)" ::: "memory")
__device__ __forceinline__ unsigned f2bf(float f) { unsigned u = __builtin_bit_cast(unsigned, f); return (u + 0x7fffu + ((u >> 16) & 1u)) >> 16; }
__device__ __forceinline__ unsigned cvtpk(float lo, float hi) { typedef float f2 __attribute__((ext_vector_type(2))); typedef __bf16 b2 __attribute__((ext_vector_type(2)));
    f2 v = {lo, hi}; b2 b = __builtin_convertvector(v, b2); return __builtin_bit_cast(unsigned, b); }
__device__ __forceinline__ unsigned pk2(float lo, float hi) { return cvtpk(lo, hi); }
__device__ __forceinline__ float bflo(unsigned w) { return __builtin_bit_cast(float, w << 16); }
__device__ __forceinline__ float bfhi(unsigned w) { return __builtin_bit_cast(float, w & 0xffff0000u); }
__device__ __forceinline__ float bf1(bf16 v) { return __builtin_bit_cast(float, (unsigned)v << 16); }
__device__ __forceinline__ float wave_sum(float v) {
#pragma unroll
    for (int o = 1; o < 64; o <<= 1) v += __shfl_xor(v, o);
    return v;
}
__device__ __forceinline__ unsigned wave_sum_u(unsigned v) {
#pragma unroll
    for (int o = 1; o < 64; o <<= 1) v += (unsigned)__shfl_xor((int)v, o);
    return v;
}
__device__ __forceinline__ float sigmoidf_(float v) { return __builtin_amdgcn_rcpf(1.0f + __builtin_amdgcn_exp2f(-v * LOG2E)); }
#define XB_TMO      128
#define XB_XCNT(j)  (256  + 64 * (j))
#define XB_XSUB(j)  (1280 + 64 * (j))
#define XB_XGEN(j)  (2304 + 64 * (j))
#define XB_TOP      3328
#define XB_TOPGEN   3392
#define XCD_BAR_WORDS 3456
#define XB_SPIN_CAP (1u << 18)

__device__ __forceinline__ unsigned xb_ld(unsigned* p)              { return __hip_atomic_load(p, __ATOMIC_RELAXED, __HIP_MEMORY_SCOPE_AGENT); }
__device__ __forceinline__ unsigned xb_add(unsigned* p, unsigned v) { return __hip_atomic_fetch_add(p, v, __ATOMIC_RELAXED, __HIP_MEMORY_SCOPE_AGENT); }
__device__ __forceinline__ unsigned xb_xcc_id() { return (unsigned)__builtin_amdgcn_s_getreg((3 << 11) | 20) & 0xFu; }
#define XB_SPIN(cond, bar) do { unsigned _sp = 0; while (cond) { __builtin_amdgcn_s_sleep(1); \
    if ((++_sp & 255u) == 0u) { if (xb_ld(&(bar)[XB_TMO])) break; if (_sp > XB_SPIN_CAP) { atomicAdd(&(bar)[XB_TMO], 1u); break; } } } } while (0)

struct XcdBarrier {
    unsigned* bar; unsigned x;
    volatile LAS unsigned* st;
};

__device__ __forceinline__ XcdBarrier xcd_barrier_post(unsigned* bar, volatile LAS unsigned* st) {
    XcdBarrier b; b.bar = bar; b.x = xb_xcc_id(); b.st = st;
    if (threadIdx.x == 0) (void)xb_add(&bar[XB_XCNT(b.x)], 1u);
    return b;
}
__device__ __forceinline__ void xcd_barrier_complete(unsigned* bar, unsigned x, unsigned& nloc, unsigned& nx) {
    const unsigned G = gridDim.x * gridDim.y * gridDim.z;
    unsigned sum, cnt, mine, sp = 0u;
    for (;;) {
        sum = 0u; cnt = 0u; mine = 0u;
#pragma unroll
        for (unsigned j = 0; j < 16; ++j) { const unsigned c = xb_ld(&bar[XB_XCNT(j)]); sum += c; cnt += (c > 0u) ? 1u : 0u; mine = (j == x) ? c : mine; }
        if (sum == G) break;
        __builtin_amdgcn_s_sleep(1);
        if ((++sp & 255u) == 0u) { if (xb_ld(&bar[XB_TMO])) break; if (sp > XB_SPIN_CAP) { atomicAdd(&bar[XB_TMO], 1u); break; } }
    }
    nloc = mine > 0u ? mine : 1u; nx = cnt > 0u ? cnt : 1u;
}

__device__ __forceinline__ void xcd_barrier(const XcdBarrier& b) {
    asm volatile("s_waitcnt vmcnt(0)" ::: "memory");
    __syncthreads();
    if (threadIdx.x == 0) {
        unsigned* bar = b.bar;
        __builtin_amdgcn_s_waitcnt(0);
        unsigned nloc = b.st[0], nx = b.st[1];
        if (nloc == 0u) { xcd_barrier_complete(bar, b.x, nloc, nx); b.st[0] = nloc; b.st[1] = nx; }
        const unsigned old = xb_add(&bar[XB_XSUB(b.x)], 1u);
        const unsigned gen = old / nloc;
        if (old + 1u == (gen + 1u) * nloc) {
            __builtin_amdgcn_fence(__ATOMIC_RELEASE, "agent");
            asm volatile("s_waitcnt vmcnt(0)" ::: "memory");
            const unsigned og = xb_add(&bar[XB_TOP], 1u);
            const unsigned tg = og / nx;
            if (og + 1u == (tg + 1u) * nx) xb_add(&bar[XB_TOPGEN], 1u);
            else XB_SPIN(xb_ld(&bar[XB_TOPGEN]) == tg, bar);
            __builtin_amdgcn_fence(__ATOMIC_ACQUIRE, "agent");
            xb_add(&bar[XB_XGEN(b.x)], 1u);
            asm volatile("s_waitcnt vmcnt(0)" ::: "memory");
        } else {
            XB_SPIN(xb_ld(&bar[XB_XGEN(b.x)]) == gen, bar);
            __builtin_amdgcn_fence(__ATOMIC_ACQUIRE, "agent");
            asm volatile("s_waitcnt vmcnt(0)" ::: "memory");
        }
    }
    __syncthreads();
}

struct Args { const float* in[17]; float* out; unsigned char* ws; int ph_lo, ph_hi; };
struct Frame {
    LAS unsigned char* lds;
    int tid, lane, wave, vcu, G, bx;
    const float* const* in;
    GAS float* X; GAS unsigned char* ws;
};
#define INP(F, k) ((const GAS float*)(F).in[k])
#define IN_X 0
#define IN_P 1
#define IN_RELB 2
#define IN_GMIXPRE 3
#define IN_WIN 4
#define IN_CONVW 5
#define IN_POOLW 6
#define IN_POOLS 7
#define IN_WOUT 8
#define IN_GMIXPOST 9
#define IN_GFFNPRE 10
#define IN_WGU 11
#define IN_WDOWN 12
#define IN_GFFNPOST 13
#define IN_GPLE 14
#define IN_WPLEG 15
#define IN_WPLEP 16

typedef pg8::f32x4 (&AccRef)[2][2][4][2];
typedef const pg8::f32x4 (&AccCRef)[2][2][4][2];
__device__ __forceinline__ float dot4(f32x4 a) { return (a[0] * a[0] + a[1] * a[1]) + (a[2] * a[2] + a[3] * a[3]); }

struct EpiZ {
    static constexpr bool PERM = true, AFTER_DRAIN = false;
    GAS bf16* Z; const GAS float* rssp;
    __device__ __forceinline__ void operator()(AccCRef acc, const pg8::Unit& u, int wr, int wc, int fr, int fq) const {
        const int row0 = u.pm * 256 + wr * 64 + fr, col0 = u.pn * 256 + wc * 32 + 8 * fq;
#pragma unroll
        for (int ai = 0; ai < 2; ++ai)
#pragma unroll
            for (int m = 0; m < 4; ++m) {
                const int row = row0 + ai * 128 + m * 16;
                const GAS f32x4* rp = (const GAS f32x4*)(rssp + (size_t)row * 16);
                const f32x4 a = rp[0], b = rp[1], c = rp[2], d = rp[3];
                const float ss = ((a[0] + a[1]) + (a[2] + a[3])) + ((b[0] + b[1]) + (b[2] + b[3])) + ((c[0] + c[1]) + (c[2] + c[3])) + ((d[0] + d[1]) + (d[2] + d[3]));
                const float rs = rsqrtf(ss * (1.0f / DM) + RMS_EPS);
                GAS bf16* rowp = Z + (size_t)row * ZP + col0;
#pragma unroll
                for (int bj = 0; bj < 2; ++bj) {
                    const f32x4 v0 = acc[ai][bj][m][0] * rs, v1 = acc[ai][bj][m][1] * rs;
                    v4u w; w.x = pk2(v0[0], v0[1]); w.y = pk2(v0[2], v0[3]); w.z = pk2(v1[0], v1[1]); w.w = pk2(v1[2], v1[3]);
                    *(GAS v4u*)(rowp + bj * 128) = w;
                }
            }
    }
};
struct EpiT {
    static constexpr bool PERM = true, AFTER_DRAIN = false;
    GAS bf16* T; GAS float* rssp;
    __device__ __forceinline__ void operator()(AccCRef acc, const pg8::Unit& u, int wr, int wc, int fr, int fq) const {
        const int row0 = u.pm * 256 + wr * 64 + fr, col0 = u.pn * 256 + wc * 32 + 8 * fq;
#pragma unroll
        for (int ai = 0; ai < 2; ++ai)
#pragma unroll
            for (int m = 0; m < 4; ++m) {
                const int row = row0 + ai * 128 + m * 16;
                GAS bf16* rowp = T + (size_t)row * DM + col0;
                float ss = 0.f;
#pragma unroll
                for (int bj = 0; bj < 2; ++bj) {
                    const f32x4 v0 = acc[ai][bj][m][0], v1 = acc[ai][bj][m][1];
                    ss += dot4(v0) + dot4(v1);
                    v4u w; w.x = pk2(v0[0], v0[1]); w.y = pk2(v0[2], v0[3]); w.z = pk2(v1[0], v1[1]); w.w = pk2(v1[2], v1[3]);
                    *(GAS v4u*)(rowp + bj * 128) = w;
                }
                ss += __shfl_xor(ss, 16); ss += __shfl_xor(ss, 32);
                if (fq == 0) rssp[(size_t)row * 16 + u.pn * 4 + wc] = ss;
            }
    }
};
struct EpiB {
    static constexpr bool PERM = true, AFTER_DRAIN = false;
    GAS bf16* T;
    __device__ __forceinline__ void operator()(AccCRef acc, const pg8::Unit& u, int wr, int wc, int fr, int fq) const {
        const int row0 = u.pm * 256 + wr * 64 + fr, col0 = u.pn * 256 + wc * 32 + 8 * fq;
#pragma unroll
        for (int ai = 0; ai < 2; ++ai)
#pragma unroll
            for (int m = 0; m < 4; ++m) {
                GAS bf16* rowp = T + (size_t)(row0 + ai * 128 + m * 16) * DM + col0;
#pragma unroll
                for (int bj = 0; bj < 2; ++bj) {
                    const f32x4 v0 = acc[ai][bj][m][0], v1 = acc[ai][bj][m][1];
                    v4u w; w.x = pk2(v0[0], v0[1]); w.y = pk2(v0[2], v0[3]); w.z = pk2(v1[0], v1[1]); w.w = pk2(v1[2], v1[3]);
                    *(GAS v4u*)(rowp + bj * 128) = w;
                }
            }
    }
};
struct EpiSwiGLU {
    static constexpr bool PERM = true, AFTER_DRAIN = false;
    GAS bf16* H; const GAS float* rss1;
    __device__ __forceinline__ void operator()(AccCRef acc, const pg8::Unit& u, int wr, int wc, int fr, int fq) const {
        const int row0 = u.pm * 256 + wr * 64 + fr, col0 = u.pn * 128 + wc * 32 + 8 * fq;
#pragma unroll
        for (int ai = 0; ai < 2; ++ai)
#pragma unroll
            for (int m = 0; m < 4; ++m) {
                const int row = row0 + ai * 128 + m * 16;
                const float rs = rsqrtf(rss1[row] * (1.0f / DM) + RMS_EPS);
                float h[8];
#pragma unroll
                for (int n = 0; n < 2; ++n)
#pragma unroll
                    for (int j = 0; j < 4; ++j) { const float g = acc[ai][0][m][n][j] * rs, up = acc[ai][1][m][n][j] * rs; h[n * 4 + j] = g * up * sigmoidf_(g); }
                v4u w; w.x = pk2(h[0], h[1]); w.y = pk2(h[2], h[3]); w.z = pk2(h[4], h[5]); w.w = pk2(h[6], h[7]);
                *(GAS v4u*)(H + (size_t)row * DFF + col0) = w;
            }
    }
};
struct EpiPLE {
    static constexpr bool PERM = false, AFTER_DRAIN = false;
    GAS float* X; GAS bf16* XB; const GAS bf16* T2; const GAS float* rss1; GAS float* rssp;
    __device__ __forceinline__ void operator()(AccCRef acc, const pg8::Unit& u, int wr, int wc, int fr, int fq) const {
        const int row0 = u.pm * 256 + wr * 64 + fr, col0 = u.pn * 256 + wc * 32 + 4 * fq;
#pragma unroll
        for (int ai = 0; ai < 2; ++ai)
#pragma unroll
            for (int m = 0; m < 4; ++m) {
                const int row = row0 + ai * 128 + m * 16;
                const float rs = rsqrtf(rss1[row] * (1.0f / DM) + RMS_EPS);
                float ss = 0.f;
#pragma unroll
                for (int bj = 0; bj < 2; ++bj)
#pragma unroll
                    for (int n = 0; n < 2; ++n) {
                        const size_t off = (size_t)row * DM + col0 + bj * 128 + n * 16;
                        const f32x4 xo = *(const GAS f32x4*)(X + off); const v2u t2 = *(const GAS v2u*)(T2 + off);
                        const f32x4 a = acc[ai][bj][m][n] * rs;
                        f32x4 xn;
                        xn[0] = xo[0] + sigmoidf_(a[0]) * bflo(t2.x); xn[1] = xo[1] + sigmoidf_(a[1]) * bfhi(t2.x);
                        xn[2] = xo[2] + sigmoidf_(a[2]) * bflo(t2.y); xn[3] = xo[3] + sigmoidf_(a[3]) * bfhi(t2.y);
                        ss += dot4(xn);
                        *(GAS f32x4*)(X + off) = xn;
                        v2u w; w.x = pk2(xn[0], xn[1]); w.y = pk2(xn[2], xn[3]); *(GAS v2u*)(XB + off) = w;
                    }
                ss += __shfl_xor(ss, 16); ss += __shfl_xor(ss, 32);
                if (fq == 0) rssp[(size_t)row * 16 + u.pn * 4 + wc] = ss;
            }
    }
};

__device__ __forceinline__ int win_src(int n) {
    if (n < 1280) return n;
    if (n < 1536) return 2376 + (n - 1280);
    if (n < 1792) return 1280 + (n - 1536);
    if (n < 2048) return 2632 + (n - 1792);
    if (n < 2304) return 1536 + (n - 2048);
    if (n < 2560) return 2888 + (n - 2304);
    if (n < 3072) return 1792 + (n - 2560);
    if (n < 3136) return 2304 + (n - 3072);
    if (n < 3144) return 2368 + (n - 3136);
    return -1;
}
struct TrDesc { const GAS float* W; const GAS float* g; GAS bf16* WT; int K, Nsrc, map, k0, n0; };
constexpr int TR_I_WIN = (DM / 128) * (ZP / 64), TR_I_WOUT = (DM / 128) * (DM / 64), TR_I_WGU = (DM / 128) * (2 * DFF / 64), TR_I_WD = (DFF / 128) * (DM / 64), TR_I_WG = TR_I_WOUT, TR_I_WP = (PLE / 128) * (DM / 64);
constexpr int TR_I_LAYER = TR_I_WIN + TR_I_WOUT + TR_I_WGU + TR_I_WD + TR_I_WG + TR_I_WP;
__device__ __forceinline__ TrDesc tr_desc(const Frame& F, int L, int r) {
    GAS unsigned char* wl = F.ws + WS_W + (size_t)L * LW_BYTES;
    TrDesc d; int nblk;
    if (r < TR_I_WIN) { d.W = INP(F, IN_WIN) + (size_t)L * DM * NIN; d.g = INP(F, IN_GMIXPRE) + L * DM; d.WT = (GAS bf16*)(wl + LW_WIN); d.K = DM; d.Nsrc = NIN; d.map = 1; nblk = ZP / 64; }
    else if ((r -= TR_I_WIN) < TR_I_WOUT) { d.W = INP(F, IN_WOUT) + (size_t)L * DM * DM; d.g = nullptr; d.WT = (GAS bf16*)(wl + LW_WOUT); d.K = DM; d.Nsrc = DM; d.map = 0; nblk = DM / 64; }
    else if ((r -= TR_I_WOUT) < TR_I_WGU) { d.W = INP(F, IN_WGU) + (size_t)L * DM * 2 * DFF; d.g = INP(F, IN_GFFNPRE) + L * DM; d.WT = (GAS bf16*)(wl + LW_WGU); d.K = DM; d.Nsrc = 2 * DFF; d.map = 2; nblk = 2 * DFF / 64; }
    else if ((r -= TR_I_WGU) < TR_I_WD) { d.W = INP(F, IN_WDOWN) + (size_t)L * DFF * DM; d.g = nullptr; d.WT = (GAS bf16*)(wl + LW_WD); d.K = DFF; d.Nsrc = DM; d.map = 0; nblk = DM / 64; }
    else if ((r -= TR_I_WD) < TR_I_WG) { d.W = INP(F, IN_WPLEG) + (size_t)L * DM * DM; d.g = INP(F, IN_GPLE) + L * DM; d.WT = (GAS bf16*)(wl + LW_WG); d.K = DM; d.Nsrc = DM; d.map = 0; nblk = DM / 64; }
    else { r -= TR_I_WG; d.W = INP(F, IN_WPLEP) + (size_t)L * PLE * DM; d.g = nullptr; d.WT = (GAS bf16*)(wl + LW_WP); d.K = PLE; d.Nsrc = DM; d.map = 0; nblk = DM / 64; }
    d.k0 = 128 * (r / nblk); d.n0 = 64 * (r % nblk);
    return d;
}
__device__ __forceinline__ void tr_load(const TrDesc& d, int tid, f32x4 (&v)[4], float& cs) {
    const int nd = d.n0 + (tid & 15) * 4; int ns = nd; cs = 1.0f;
    if (d.map == 1) { ns = win_src(nd); if (nd >= ZC_Q && nd < ZC_K) cs = C2; }
    else if (d.map == 2) { const int pn = nd >> 8, r = nd & 255; ns = (r < 128) ? (pn * 128 + r) : (DFF + pn * 128 + (r - 128)); }
#pragma unroll
    for (int p = 0; p < 4; ++p) { const int kk = d.k0 + p * 32 + (tid >> 4);
        v[p] = (ns >= 0) ? *(const GAS f32x4*)(d.W + (size_t)kk * d.Nsrc + ns) : (f32x4){0.f, 0.f, 0.f, 0.f};
        if (d.g) v[p] = v[p] * d.g[kk]; }
}
__device__ __forceinline__ void convert_weights(const Frame& F, int L, int first, int stride) {
    LAS bf16* tl = (LAS bf16*)F.lds; const int tid = F.tid;
    if (first >= TR_I_LAYER) return;
    TrDesc d = tr_desc(F, L, first); f32x4 v[4]; float cs;
    tr_load(d, tid, v, cs);
    for (int it = first; it < TR_I_LAYER; it += stride) {
        const int nl = (tid & 15) * 4;
#pragma unroll
        for (int p = 0; p < 4; ++p) { const int kk = p * 32 + (tid >> 4);
#pragma unroll
            for (int e = 0; e < 4; ++e) tl[(nl + e) * 136 + kk] = (bf16)f2bf(v[p][e] * cs); }
        __syncthreads();
        const TrDesc dc = d;
        if (it + stride < TR_I_LAYER) { d = tr_desc(F, L, it + stride); tr_load(d, tid, v, cs); }
#pragma unroll
        for (int j = 0; j < 2; ++j) { const int chunk = tid + 512 * j, n = chunk >> 4, c8 = (chunk & 15) * 8;
            const v4u o = *(const LAS v4u*)(tl + n * 136 + c8);
            *(GAS v4u*)(dc.WT + (size_t)(dc.n0 + n) * dc.K + dc.k0 + c8) = o; }
        __syncthreads();
    }
}
__device__ __forceinline__ void phase_prologue(const Frame& F) {
    const int gw = F.vcu * NWAVES + F.wave, NGW = F.G * NWAVES, lane = F.lane;
    for (int L = 0; L < DEPTH; ++L) convert_weights(F, L, F.vcu, F.G);
    {
        const GAS f32x4* src = (const GAS f32x4*)INP(F, IN_P); GAS v2u* dst = (GAS v2u*)(F.ws + WS_PB);
        const size_t n4 = (size_t)DEPTH * M * PLE / 4, T = (size_t)F.G * NTHREADS;
        for (size_t i = (size_t)F.vcu * NTHREADS + F.tid; i < n4; i += 4 * T) {
            f32x4 v[4];
#pragma unroll
            for (int j = 0; j < 4; ++j) if (i + j * T < n4) v[j] = src[i + j * T];
#pragma unroll
            for (int j = 0; j < 4; ++j) if (i + j * T < n4) { v2u w; w.x = pk2(v[j][0], v[j][1]); w.y = pk2(v[j][2], v[j][3]); dst[i + j * T] = w; }
        }
    }
    {
        const GAS float* x = INP(F, IN_X); GAS bf16* XB = (GAS bf16*)(F.ws + WS_XB); GAS float* rssp = (GAS float*)(F.ws + WS_RSSPX);
        for (int row = gw; row < M; row += NGW) {
            const GAS f32x4* xr = (const GAS f32x4*)(x + (size_t)row * DM) + lane; GAS f32x4* xo = (GAS f32x4*)(F.X + (size_t)row * DM) + lane; GAS v2u* xb = (GAS v2u*)(XB + (size_t)row * DM) + lane;
            float ss = 0.f;
#pragma unroll
            for (int j = 0; j < 4; ++j) { const f32x4 v = xr[64 * j]; ss += dot4(v); xo[64 * j] = v; v2u w; w.x = pk2(v[0], v[1]); w.y = pk2(v[2], v[3]); xb[64 * j] = w; }
            ss = wave_sum(ss);
            if (lane < 16) rssp[(size_t)row * 16 + lane] = (lane == 0) ? ss : 0.f;
        }
    }
}

__device__ __forceinline__ void phase_resid(const Frame& F, const GAS bf16* T, const GAS float* rsspt, const GAS float* g) {
    const int gw = F.vcu * NWAVES + F.wave, NGW = F.G * NWAVES, lane = F.lane;
    GAS bf16* XB = (GAS bf16*)(F.ws + WS_XB); GAS float* rss1 = (GAS float*)(F.ws + WS_RSS1);
    f32x4 gv[4];
#pragma unroll
    for (int j = 0; j < 4; ++j) gv[j] = ((const GAS f32x4*)g)[lane + 64 * j];
    for (int row = gw; row < M; row += NGW) {
        const GAS f32x4* rp = (const GAS f32x4*)(rsspt + (size_t)row * 16);
        const f32x4 a = rp[0], b = rp[1], c = rp[2], d = rp[3];
        const float st = ((a[0] + a[1]) + (a[2] + a[3])) + ((b[0] + b[1]) + (b[2] + b[3])) + ((c[0] + c[1]) + (c[2] + c[3])) + ((d[0] + d[1]) + (d[2] + d[3]));
        const float rs = rsqrtf(st * (1.0f / DM) + RMS_EPS);
        GAS f32x4* xr = (GAS f32x4*)(F.X + (size_t)row * DM) + lane; const GAS v2u* tr = (const GAS v2u*)(T + (size_t)row * DM) + lane; GAS v2u* xb = (GAS v2u*)(XB + (size_t)row * DM) + lane;
        float ss = 0.f;
#pragma unroll
        for (int j = 0; j < 4; ++j) {
            f32x4 v = xr[64 * j]; const v2u t = tr[64 * j];
            v[0] += gv[j][0] * bflo(t.x) * rs; v[1] += gv[j][1] * bfhi(t.x) * rs; v[2] += gv[j][2] * bflo(t.y) * rs; v[3] += gv[j][3] * bfhi(t.y) * rs;
            ss += dot4(v); xr[64 * j] = v; v2u w; w.x = pk2(v[0], v[1]); w.y = pk2(v[2], v[3]); xb[64 * j] = w;
        }
        ss = wave_sum(ss);
        if (lane == 0) rss1[row] = ss;
    }
}

__device__ __forceinline__ void phase_prep(const Frame& F, int L) {
    const GAS bf16* Z = (const GAS bf16*)(F.ws + WS_RZ); GAS bf16* MIX = (GAS bf16*)(F.ws + WS_RM);
    const int tid = F.tid, lane = F.lane, wave = F.wave;
    {
        const GAS float* cw = INP(F, IN_CONVW) + (size_t)L * 3 * 256;
        for (size_t i = (size_t)F.vcu * NTHREADS + tid; i < (size_t)M * 32; i += (size_t)F.G * NTHREADS) {
            const int row = (int)(i >> 5), c0 = (int)(i & 31) * 8, t = row & (SEQ - 1);
            float accv[8];
#pragma unroll
            for (int e = 0; e < 8; ++e) accv[e] = 0.f;
#pragma unroll
            for (int j = 0; j < 3; ++j) {
                const int tt = t - 2 + j;
                if (tt >= 0) {
                    const GAS bf16* zr = Z + (size_t)(row - 2 + j) * ZP;
                    const v4u ain = *(const GAS v4u*)(zr + ZC_AIN + c0), ac = *(const GAS v4u*)(zr + ZC_AC + c0);
                    const f32x4 w0 = *(const GAS f32x4*)(cw + j * 256 + c0), w1 = *(const GAS f32x4*)(cw + j * 256 + c0 + 4);
                    accv[0] += w0[0] * bflo(ain.x) * bflo(ac.x); accv[1] += w0[1] * bfhi(ain.x) * bfhi(ac.x);
                    accv[2] += w0[2] * bflo(ain.y) * bflo(ac.y); accv[3] += w0[3] * bfhi(ain.y) * bfhi(ac.y);
                    accv[4] += w1[0] * bflo(ain.z) * bflo(ac.z); accv[5] += w1[1] * bfhi(ain.z) * bfhi(ac.z);
                    accv[6] += w1[2] * bflo(ain.w) * bflo(ac.w); accv[7] += w1[3] * bfhi(ain.w) * bfhi(ac.w);
                }
            }
            const v4u ab = *(const GAS v4u*)(Z + (size_t)row * ZP + ZC_AB + c0);
            v4u o; o.x = pk2(accv[0] * bflo(ab.x), accv[1] * bfhi(ab.x)); o.y = pk2(accv[2] * bflo(ab.y), accv[3] * bfhi(ab.y));
            o.z = pk2(accv[4] * bflo(ab.z), accv[5] * bfhi(ab.z)); o.w = pk2(accv[6] * bflo(ab.w), accv[7] * bfhi(ab.w));
            *(GAS v4u*)(MIX + (size_t)row * DM + c0) = o;
        }
    }
    {
        LAS float* Vs = (LAS float*)F.lds; LAS float* Ds = (LAS float*)(F.lds + 49152);
        const GAS float* pw = INP(F, IN_POOLW) + (size_t)L * 4 * 64 * 64; const GAS float* ps = INP(F, IN_POOLS) + (size_t)L * 256;
        const int oc = tid & 255, og = oc >> 6, oo = oc & 63, th = tid >> 8;
        float wreg[64];
#pragma unroll
        for (int c = 0; c < 64; ++c) wreg[c] = pw[(og * 64 + c) * 64 + oo];
        const float psc = ps[oc];
        for (int tile = F.vcu; tile < M / 32; tile += F.G) {
            const int row0 = tile * 32, t0 = row0 & (SEQ - 1);
            __syncthreads();
            for (int i = tid; i < 48 * 32; i += NTHREADS) {
                const int r = i >> 5, c0 = (i & 31) * 8, tt = t0 - 16 + r;
                float v[8];
                if (tt >= 0) { const v4u z = *(const GAS v4u*)(Z + (size_t)(row0 - 16 + r) * ZP + ZC_PV + c0);
                    v[0] = bflo(z.x); v[1] = bfhi(z.x); v[2] = bflo(z.y); v[3] = bfhi(z.y); v[4] = bflo(z.z); v[5] = bfhi(z.z); v[6] = bflo(z.w); v[7] = bfhi(z.w); }
                else {
#pragma unroll
                    for (int e = 0; e < 8; ++e) v[e] = 0.f; }
#pragma unroll
                for (int e = 0; e < 8; ++e) Vs[r * 256 + c0 + e] = v[e];
            }
            __syncthreads();
            {
                const int w = 2 << og;
                for (int tl = th * 16; tl < th * 16 + 16; ++tl) {
                    float s = 0.f;
                    for (int j = 0; j < w; ++j) s += Vs[(tl + 16 - j) * 256 + oc];
                    const int tg = t0 + tl; const int cnt = (tg + 1 < w) ? (tg + 1) : w;
                    Ds[tl * 256 + oc] = s / (float)cnt - Vs[(tl + 16) * 256 + oc];
                }
            }
            __syncthreads();
            for (int tl = th * 16; tl < th * 16 + 16; ++tl) {
                const LAS f32x4* dr = (const LAS f32x4*)(Ds + tl * 256 + og * 64);
                float a = 0.f;
#pragma unroll
                for (int c4 = 0; c4 < 16; ++c4) { const f32x4 d = dr[c4]; a += d[0] * wreg[4 * c4] + d[1] * wreg[4 * c4 + 1] + d[2] * wreg[4 * c4 + 2] + d[3] * wreg[4 * c4 + 3]; }
                MIX[(size_t)(row0 + tl) * DM + 256 + oc] = (bf16)f2bf(a * psc);
            }
        }
        __syncthreads();
    }
    {
        GAS bf16* Vt = (GAS bf16*)(F.ws + WS_VT);
        LAS bf16* tl = (LAS bf16*)(F.lds + wave * 16384);
        const int gw = F.vcu * NWAVES + wave, NGW = F.G * NWAVES;
        for (int it = gw; it < NB * 8 * (SEQ / 64); it += NGW) {
            const int st = it & 63, bh = it >> 6, b = bh >> 3, h = bh & 7;
            const GAS bf16* src = Z + (size_t)(b * SEQ + st * 64 + lane) * ZP + ZC_V + h * 64;
#pragma unroll
            for (int c = 0; c < 8; ++c) { const v4u v = *(const GAS v4u*)(src + c * 8);
                const unsigned ww[4] = {v.x, v.y, v.z, v.w};
#pragma unroll
                for (int e = 0; e < 4; ++e) { tl[(c * 8 + 2 * e) * 66 + lane] = (bf16)(ww[e] & 0xffffu); tl[(c * 8 + 2 * e + 1) * 66 + lane] = (bf16)(ww[e] >> 16); } }
            LDS_WAIT(); asm volatile("" ::: "memory");
            GAS bf16* dst = Vt + ((size_t)bh * 64 + lane) * SEQ + st * 64;
#pragma unroll
            for (int c = 0; c < 8; ++c) { v4u o; const LAS unsigned* s = (const LAS unsigned*)(tl + lane * 66 + c * 8); o.x = s[0]; o.y = s[1]; o.z = s[2]; o.w = s[3]; *(GAS v4u*)(dst + c * 8) = o; }
            LDS_WAIT(); asm volatile("" ::: "memory");
        }
    }
    {
        GAS float* KM = (GAS float*)(F.ws + WS_KM);
        LAS float* red = (LAS float*)F.lds;
        for (int it = F.vcu; it < NB * 16; it += F.G) {
            const int cg = tid & 31, rg = tid >> 5;
            const GAS bf16* src = Z + (size_t)(it * 256 + rg * 16) * ZP + ZC_K + 256 + cg * 8;
            float s[8];
#pragma unroll
            for (int e = 0; e < 8; ++e) s[e] = 0.f;
#pragma unroll 4
            for (int r = 0; r < 16; ++r) { const v4u v = *(const GAS v4u*)(src + (size_t)r * ZP);
                s[0] += bflo(v.x); s[1] += bfhi(v.x); s[2] += bflo(v.y); s[3] += bfhi(v.y); s[4] += bflo(v.z); s[5] += bfhi(v.z); s[6] += bflo(v.w); s[7] += bfhi(v.w); }
            __syncthreads();
#pragma unroll
            for (int e = 0; e < 8; ++e) red[rg * 256 + cg * 8 + e] = s[e];
            __syncthreads();
            if (tid < 256) { float a = 0.f;
#pragma unroll
                for (int g = 0; g < 16; ++g) a += red[g * 256 + tid];
                KM[(size_t)it * 256 + tid] = a * (1.0f / 256.0f); }
        }
        __syncthreads();
    }
}

typedef unsigned short u16x2 __attribute__((ext_vector_type(2)));
__device__ __forceinline__ void cnt_acc(unsigned& acc, unsigned w, unsigned kk) { acc = __builtin_amdgcn_udot4((w + kk) & 0x80008000u, 0x01010101u, acc, false); }
__device__ __forceinline__ void cnt_acc4(unsigned& acc, v4u v, unsigned kk) { cnt_acc(acc, v.x, kk); cnt_acc(acc, v.y, kk); cnt_acc(acc, v.z, kk); cnt_acc(acc, v.w, kk); }
template <int CTRL, int ROWMASK> __device__ __forceinline__ unsigned dpp_add(unsigned v) { return v + (unsigned)__builtin_amdgcn_update_dpp(0, (int)v, CTRL, ROWMASK, 0xf, false); }
__device__ __forceinline__ unsigned wave_scan_incl(unsigned v) {
    v = dpp_add<0x111, 0xf>(v); v = dpp_add<0x112, 0xf>(v); v = dpp_add<0x114, 0xf>(v); v = dpp_add<0x118, 0xf>(v);
    v = dpp_add<0x142, 0xa>(v); v = dpp_add<0x143, 0xc>(v);
    return v;
}
__device__ __forceinline__ unsigned wave_total(unsigned v) { return (unsigned)__builtin_amdgcn_readlane((int)wave_scan_incl(v), 63); }
__device__ __forceinline__ void count_ge2(const LAS unsigned short* rowA, const LAS unsigned short* rowB, int nchunks, unsigned candA, unsigned candB, int lane, unsigned& cA, unsigned& cB) {
    const unsigned ka = 0x8000u - candA, kb = 0x8000u - candB;
    const unsigned kkA = ka | (ka << 16), kkB = kb | (kb << 16);
    unsigned accA = 0, accB = 0, accA2 = 0, accB2 = 0;
    const LAS unsigned short* pa = rowA + lane * 8; const LAS unsigned short* pb = rowB + lane * 8;
    int c = 0;
    for (; c + 2 <= nchunks; c += 2) {
        const v4u va = *(const LAS v4u*)(pa + c * 512), vb = *(const LAS v4u*)(pb + c * 512), va2 = *(const LAS v4u*)(pa + c * 512 + 512), vb2 = *(const LAS v4u*)(pb + c * 512 + 512);
        cnt_acc4(accA, va, kkA); cnt_acc4(accB, vb, kkB); cnt_acc4(accA2, va2, kkA); cnt_acc4(accB2, vb2, kkB);
    }
    if (c < nchunks) { const v4u va = *(const LAS v4u*)(pa + c * 512), vb = *(const LAS v4u*)(pb + c * 512); cnt_acc4(accA, va, kkA); cnt_acc4(accB, vb, kkB); }
    cA = wave_total((accA + accA2) >> 7); cB = wave_total((accB + accB2) >> 7);
}
__device__ __forceinline__ void idx_tile(const Frame& F, int b, int qt) {
    const GAS bf16* Z = (const GAS bf16*)(F.ws + WS_RZ); GAS u64* DMK = (GAS u64*)(F.ws + WS_DMASK);
    LAS unsigned short* keys = (LAS unsigned short*)F.lds; LAS unsigned char* mrow = (LAS unsigned char*)(F.lds + IDX_MROW_OFF);
    const int tid = F.tid, lane = F.lane, wave = F.wave, q0 = qt * 16;
    if (qt < 16) {
        for (int i = tid; i < 16 * 512; i += NTHREADS) { const int qi = i >> 9, bi = i & 511, q = q0 + qi, k0 = bi * 8;
            mrow[i] = (unsigned char)((k0 + 7 <= q) ? 0xFFu : ((k0 > q) ? 0u : ((1u << (q - k0 + 1)) - 1u))); }
    } else {
        const int nchunks = (q0 + 16 + 511) >> 9;
        const size_t rb = (size_t)b * SEQ;
#ifndef IDX_REP_SCORE
#define IDX_REP_SCORE 1
#endif
#ifndef IDX_REP_SEL
#define IDX_REP_SEL 1
#endif
        for (int rep_ = 0; rep_ < IDX_REP_SCORE; ++rep_)
        {
            const int fr = lane & 15, fq = lane >> 4;
            bf16x8 Bq[8][2];
            const GAS bf16* qrow = Z + (rb + q0 + fr) * ZP + ZC_IQ + fq * 8;
#pragma unroll
            for (int h = 0; h < 8; ++h)
#pragma unroll
                for (int ks = 0; ks < 2; ++ks) Bq[h][ks] = *(const GAS bf16x8*)(qrow + h * 64 + ks * 32);
            float iw[8];
            { const v4u w = *(const GAS v4u*)(Z + (rb + q0 + fr) * ZP + ZC_IW);
              iw[0] = bflo(w.x); iw[1] = bfhi(w.x); iw[2] = bflo(w.y); iw[3] = bfhi(w.y); iw[4] = bflo(w.z); iw[5] = bfhi(w.z); iw[6] = bflo(w.w); iw[7] = bfhi(w.w); }
            const int ntl = qt + 1, ntl_pad = nchunks * 32;
            const GAS bf16* kbase = Z + (rb + fr) * ZP + ZC_IK + fq * 8;
            bf16x8 A0n, A1n, A0m, A1m;
            { const GAS bf16* krow = kbase + (size_t)(wave * 16) * ZP; A0n = *(const GAS bf16x8*)(krow); A1n = *(const GAS bf16x8*)(krow + 32); }
            { const GAS bf16* krow = kbase + (size_t)((wave + NWAVES) * 16) * ZP; A0m = *(const GAS bf16x8*)(krow); A1m = *(const GAS bf16x8*)(krow + 32); }
            for (int kt = wave; kt < ntl_pad; kt += NWAVES) {
                v2u outw;
                if (kt < ntl) {
                    const bf16x8 A0 = A0n, A1 = A1n;
                    A0n = A0m; A1n = A1m;
                    if (kt + 2 * NWAVES < ntl) { const GAS bf16* krow = kbase + (size_t)((kt + 2 * NWAVES) * 16) * ZP; A0m = *(const GAS bf16x8*)(krow); A1m = *(const GAS bf16x8*)(krow + 32); }
                    float sc[4] = {0.f, 0.f, 0.f, 0.f};
#pragma unroll
                    for (int h = 0; h < 8; ++h) {
                        pg8::f32x4 acc = {0.f, 0.f, 0.f, 0.f};
                        acc = __builtin_amdgcn_mfma_f32_16x16x32_bf16(A0, Bq[h][0], acc, 0, 0, 0);
                        acc = __builtin_amdgcn_mfma_f32_16x16x32_bf16(A1, Bq[h][1], acc, 0, 0, 0);
#pragma unroll
                        for (int i = 0; i < 4; ++i) { const float av = acc[i]; int ai = __builtin_bit_cast(int, av); ai = ai < 0 ? 0 : ai;
                            sc[i] += iw[h] * __builtin_bit_cast(float, ai); }
                    }
                    typedef _Float16 h2 __attribute__((ext_vector_type(2))); typedef short s2 __attribute__((ext_vector_type(2)));
                    const h2 p01 = {(_Float16)sc[0], (_Float16)sc[1]}, p23 = {(_Float16)sc[2], (_Float16)sc[3]};
                    const unsigned x01 = __builtin_bit_cast(unsigned, p01), x23 = __builtin_bit_cast(unsigned, p23);
                    const s2 g01 = __builtin_bit_cast(s2, x01) >> 15, g23 = __builtin_bit_cast(s2, x23) >> 15;
                    unsigned m01 = ((x01 ^ (__builtin_bit_cast(unsigned, g01) | 0x80008000u)) >> 1) & 0x7fff7fffu;
                    unsigned m23 = ((x23 ^ (__builtin_bit_cast(unsigned, g23) | 0x80008000u)) >> 1) & 0x7fff7fffu;
                    if (kt >= qt) {
                        const int kq = kt * 16 + fq * 4 - (q0 + fr);
                        if (kq > 0) m01 &= 0xffff0000u; if (kq + 1 > 0) m01 &= 0x0000ffffu; if (kq + 2 > 0) m23 &= 0xffff0000u; if (kq + 3 > 0) m23 &= 0x0000ffffu;
                    }
                    outw.x = m01; outw.y = m23;
                } else { outw.x = 0u; outw.y = 0u; }
                *(LAS v2u*)(keys + fr * 4096 + kt * 16 + fq * 4) = outw;
            }
        }
        __syncthreads();
        for (int rep_ = 0; rep_ < IDX_REP_SEL; ++rep_)
        {
            const int qa = wave, qb = wave + 8;
            const LAS unsigned short* rowA = keys + qa * 4096; const LAS unsigned short* rowB = keys + qb * 4096;
            unsigned TA = 0, TB = 0;
            for (int bit = 14; bit >= 0; --bit) {
                const unsigned ca = TA | (1u << bit), cb = TB | (1u << bit); unsigned na, nb;
                count_ge2(rowA, rowB, nchunks, ca, cb, lane, na, nb);
                if (na >= 256u) TA = ca; if (nb >= 256u) TB = cb;
            }
            unsigned gA, gB;
            count_ge2(rowA, rowB, nchunks, TA + 1u, TB + 1u, lane, gA, gB);
            const unsigned needA = 256u - gA, needB = 256u - gB;
            unsigned baseA = 0, baseB = 0;
            LAS unsigned char* mrA = mrow + qa * 512; LAS unsigned char* mrB = mrow + qb * 512;
            for (int c = 0; c < nchunks; ++c) {
#pragma unroll
                for (int s = 0; s < 2; ++s) {
                    const LAS unsigned short* row = s ? rowB : rowA; const unsigned T = s ? TB : TA, need = s ? needB : needA; unsigned& base = s ? baseB : baseA; LAS unsigned char* mr = s ? mrB : mrA;
                    const v4u v = *(const LAS v4u*)(row + c * 512 + lane * 8);
                    const unsigned ww[4] = {v.x, v.y, v.z, v.w};
                    unsigned gtb = 0, eqb = 0;
#pragma unroll
                    for (int e = 0; e < 4; ++e) { const unsigned lo = ww[e] & 0xffffu, hi = ww[e] >> 16;
                        gtb |= (lo > T ? 1u : 0u) << (2 * e); gtb |= (hi > T ? 1u : 0u) << (2 * e + 1);
                        eqb |= (lo == T ? 1u : 0u) << (2 * e); eqb |= (hi == T ? 1u : 0u) << (2 * e + 1); }
                    const unsigned ecount = (unsigned)__builtin_popcount(eqb);
                    const unsigned incl = wave_scan_incl(ecount);
                    const unsigned rank0 = base + incl - ecount; unsigned sel = gtb;
                    const int allow = (int)need - (int)rank0;
                    if (allow >= (int)ecount) sel |= eqb;
                    else if (allow > 0) { unsigned rank = 0;
#pragma unroll
                        for (int j = 0; j < 8; ++j) { if ((eqb >> j) & 1u) { if ((int)rank < allow) sel |= 1u << j; ++rank; } } }
                    mr[c * 64 + lane] = (unsigned char)sel;
                    base += (unsigned)__builtin_amdgcn_readlane((int)incl, 63);
                }
            }
            for (int i = nchunks * 64 + lane; i < 512; i += 64) { mrA[i] = 0; mrB[i] = 0; }
        }
    }
    __syncthreads();
    for (int i = tid; i < 1024; i += NTHREADS) { const int t64 = i >> 4, qi = i & 15;
        const LAS unsigned* s = (const LAS unsigned*)(mrow + qi * 512 + t64 * 8);
        DMK[((size_t)(b * 64 + t64)) * SEQ + q0 + qi] = (u64)s[0] | ((u64)s[1] << 32); }
    __syncthreads();
}
__device__ __forceinline__ void phase_index(const Frame& F) {
    for (int pi = F.vcu; pi < 512; pi += F.G) { const int b = pi >> 7, s = pi & 127; idx_tile(F, b, s); idx_tile(F, b, 255 - s); }
}

__device__ __forceinline__ int crow(int r, int hi) { return (r & 3) + 8 * (r >> 2) + 4 * hi; }
#define MFMA32(a, b, c) __builtin_amdgcn_mfma_f32_32x32x16_bf16((a), (b), (c), 0, 0, 0)
__device__ __forceinline__ float max3f(float a, float b, float c) { float r; asm("v_max3_f32 %0, %1, %2, %3" : "=v"(r) : "v"(a), "v"(b), "v"(c)); return r; }
__device__ __forceinline__ float maskneg(float p, unsigned w, int bit) {
    const int m = __builtin_amdgcn_sbfe((int)w, bit, 1);
    const int pi = __builtin_bit_cast(int, p);
    return __builtin_bit_cast(float, (pi & m) | ((int)0xff800000 & ~m));
}
__device__ __forceinline__ void attn_unit(const Frame& F, int b, int h8, int qb) {
    const GAS bf16* Z = (const GAS bf16*)(F.ws + WS_RZ); const GAS bf16* Vt = (const GAS bf16*)(F.ws + WS_VT); const GAS u64* DMK = (const GAS u64*)(F.ws + WS_DMASK);
    const GAS float* KM = (const GAS float*)(F.ws + WS_KM); GAS bf16* MIX = (GAS bf16*)(F.ws + WS_RM);
    LAS unsigned char* lds = F.lds; const LAS float* biasT = (const LAS float*)(F.lds + 32768) + h8 * 128;
    const int tid = F.tid, lane = F.lane, w = F.wave, r32 = lane & 31, hi = lane >> 5;
    const bool moba = h8 >= 4;
    const int q0 = qb * 256, qw0 = q0 + w * 32, q = qw0 + r32;
    const size_t rb = (size_t)b * SEQ;
    bf16x8 qf[4];
    { const GAS bf16* Qp = Z + (rb + q) * ZP + ZC_Q + h8 * 64 + 8 * hi;
#pragma unroll
      for (int d0 = 0; d0 < 4; ++d0) qf[d0] = *(const GAS bf16x8*)(Qp + 16 * d0); }
    unsigned selmask = 0;
    if (moba && qb > 0) {
        float qv[64];
        { const GAS bf16* Qr = Z + (rb + q) * ZP + ZC_Q + h8 * 64;
#pragma unroll
          for (int c = 0; c < 8; ++c) { const v4u v = *(const GAS v4u*)(Qr + c * 8);
              qv[c * 8 + 0] = bflo(v.x); qv[c * 8 + 1] = bfhi(v.x); qv[c * 8 + 2] = bflo(v.y); qv[c * 8 + 3] = bfhi(v.y); qv[c * 8 + 4] = bflo(v.z); qv[c * 8 + 5] = bfhi(v.z); qv[c * 8 + 6] = bflo(v.w); qv[c * 8 + 7] = bfhi(v.w); } }
        float g0 = -INFINITY, g1 = -INFINITY, g2 = -INFINITY; int i0 = -1, i1 = -1, i2 = -1;
        for (int n = 0; n < qb; ++n) {
            const GAS float* km = KM + ((size_t)(b * 16 + n) * 4 + (h8 - 4)) * 64;
            float g = 0.f;
#pragma unroll
            for (int d = 0; d < 64; ++d) g += qv[d] * km[d];
            if (g > g0) { g2 = g1; i2 = i1; g1 = g0; i1 = i0; g0 = g; i0 = n; }
            else if (g > g1) { g2 = g1; i2 = i1; g1 = g; i1 = n; }
            else if (g > g2) { g2 = g; i2 = n; }
        }
        if (i0 >= 0) selmask |= 1u << i0; if (i1 >= 0) selmask |= 1u << i1; if (i2 >= 0) selmask |= 1u << i2;
    }
    f32x16 o0, o1, cfar;
    const float biasfar = biasT[127];
#pragma unroll
    for (int r = 0; r < 16; ++r) { o0[r] = 0.f; o1[r] = 0.f; cfar[r] = biasfar; }
    float mrun = 0.f, lrun = 0.f;
    const int ntiles = 4 * (qb + 1);
    const int lrow = tid >> 3, lch = tid & 7;
    const GAS bf16* Kg = Z + (rb + lrow) * ZP + ZC_K + h8 * 64 + lch * 8;
    const GAS bf16* Vg = Vt + ((size_t)(b * 8 + h8) * 64 + lrow) * SEQ + lch * 8;
    const int kst_off = lrow * 128 + ((lch ^ ((lrow >> 1) & 7)) << 4);
    const int vg = (lrow >> 1) & 15, vst_off = lrow * 128 + ((lch ^ (vg >> 1)) << 4); const bool vswap = vg & 1;
    const GAS u64* Dq = DMK + (size_t)(b * 64) * SEQ + q;
    v4u kreg = *(const GAS v4u*)Kg, vreg = *(const GAS v4u*)Vg;
    u64 wnext = moba ? 0ull : Dq[0];
    const int ksw = (r32 >> 1) & 7, vsw = (r32 >> 1) & 15;
    for (int t = 0; t < ntiles; ++t) {
        const int buf = (t & 1) * 8192;
        { v4u vv = vreg; if (vswap) { vv.x = vreg.z; vv.y = vreg.w; vv.z = vreg.x; vv.w = vreg.y; }
          *(LAS v4u*)(lds + buf + kst_off) = kreg; *(LAS v4u*)(lds + 16384 + buf + vst_off) = vv; }
        __syncthreads();
        u64 word = wnext;
        if (t + 1 < ntiles) { kreg = *(const GAS v4u*)(Kg + (size_t)(t + 1) * 64 * ZP); vreg = *(const GAS v4u*)(Vg + (t + 1) * 64); if (!moba) wnext = Dq[(size_t)(t + 1) * SEQ]; }
        if (64 * t > qw0 + 31) continue;
        if (moba) { const int blk = t >> 2;
            if (blk == qb) { const int rel = q - 64 * t; word = (rel >= 63) ? ~0ull : ((rel < 0) ? 0ull : ((2ull << rel) - 1ull)); }
            else word = ((selmask >> blk) & 1u) ? ~0ull : 0ull; }
        if (__all(word == 0ull)) continue;
        const bool nearT = (qw0 - (64 * t + 63)) < 113;
        f32x16 p0, p1;
        { const LAS unsigned char* Kb = lds + buf + r32 * 128;
          const bf16x8 ka0 = *(const LAS bf16x8*)(Kb + (((0 + hi) ^ ksw) << 4)), kb0 = *(const LAS bf16x8*)(Kb + 4096 + (((0 + hi) ^ ksw) << 4));
          p0 = MFMA32(ka0, qf[0], cfar); p1 = MFMA32(kb0, qf[0], cfar);
#pragma unroll
          for (int d0 = 1; d0 < 4; ++d0) {
              const int ch = ((2 * d0 + hi) ^ ksw) << 4;
              const bf16x8 ka = *(const LAS bf16x8*)(Kb + ch), kb2 = *(const LAS bf16x8*)(Kb + 4096 + ch);
              p0 = MFMA32(ka, qf[d0], p0); p1 = MFMA32(kb2, qf[d0], p1); } }
        const unsigned wlo = (unsigned)word, whi = (unsigned)(word >> 32);
        if (nearT) {
            const int dbase = q - 64 * t;
#pragma unroll
            for (int r = 0; r < 16; ++r) { const int d0_ = dbase - crow(r, hi), d1_ = d0_ - 32;
                p0[r] += biasT[d0_ < 0 ? 0 : (d0_ > 127 ? 127 : d0_)] - biasfar; p1[r] += biasT[d1_ < 0 ? 0 : (d1_ > 127 ? 127 : d1_)] - biasfar; }
        }
#pragma unroll
        for (int r = 0; r < 16; ++r) { const int kv = crow(r, hi); const float a = p0[r], c = p1[r]; p0[r] = maskneg(a, wlo, kv); p1[r] = maskneg(c, whi, kv); }
        float mx = max3f(p0[0], p1[0], p0[1]);
        mx = max3f(mx, p1[1], p0[2]); mx = max3f(mx, p1[2], p0[3]); mx = max3f(mx, p1[3], p0[4]); mx = max3f(mx, p1[4], p0[5]); mx = max3f(mx, p1[5], p0[6]);
        mx = max3f(mx, p1[6], p0[7]); mx = max3f(mx, p1[7], p0[8]); mx = max3f(mx, p1[8], p0[9]); mx = max3f(mx, p1[9], p0[10]); mx = max3f(mx, p1[10], p0[11]);
        mx = max3f(mx, p1[11], p0[12]); mx = max3f(mx, p1[12], p0[13]); mx = max3f(mx, p1[13], p0[14]); mx = max3f(mx, p1[14], p0[15]); mx = max3f(mx, p1[15], mx);
        { auto rr = __builtin_amdgcn_permlane32_swap(__builtin_bit_cast(unsigned, mx), __builtin_bit_cast(unsigned, mx), false, false);
          const unsigned ra = rr[0], rc = rr[1]; mx = max3f(__builtin_bit_cast(float, ra), __builtin_bit_cast(float, rc), mx); }
        if (__any(mx > 0.f)) {
            const float dl = mx > 0.f ? mx : 0.f, alpha = __builtin_amdgcn_exp2f(-dl);
            mrun += dl; lrun *= alpha;
#pragma unroll
            for (int r = 0; r < 16; ++r) { p0[r] -= dl; p1[r] -= dl; o0[r] *= alpha; o1[r] *= alpha; cfar[r] = biasfar - mrun; }
        }
        float ls = 0.f;
#pragma unroll
        for (int r = 0; r < 16; ++r) { p0[r] = __builtin_amdgcn_exp2f(p0[r]); p1[r] = __builtin_amdgcn_exp2f(p1[r]); ls += p0[r] + p1[r]; }
        lrun += ls;
        bf16x8 pf[4];
        { v4u a; a.x = cvtpk(p0[0], p0[1]); a.y = cvtpk(p0[2], p0[3]); a.z = cvtpk(p0[4], p0[5]); a.w = cvtpk(p0[6], p0[7]); pf[0] = __builtin_bit_cast(bf16x8, a);
          a.x = cvtpk(p0[8], p0[9]); a.y = cvtpk(p0[10], p0[11]); a.z = cvtpk(p0[12], p0[13]); a.w = cvtpk(p0[14], p0[15]); pf[1] = __builtin_bit_cast(bf16x8, a);
          a.x = cvtpk(p1[0], p1[1]); a.y = cvtpk(p1[2], p1[3]); a.z = cvtpk(p1[4], p1[5]); a.w = cvtpk(p1[6], p1[7]); pf[2] = __builtin_bit_cast(bf16x8, a);
          a.x = cvtpk(p1[8], p1[9]); a.y = cvtpk(p1[10], p1[11]); a.z = cvtpk(p1[12], p1[13]); a.w = cvtpk(p1[14], p1[15]); pf[3] = __builtin_bit_cast(bf16x8, a); }
        { const LAS unsigned char* Vb = lds + 16384 + buf + r32 * 128;
#pragma unroll
          for (int ks = 0; ks < 4; ++ks) {
              const int ua = ((4 * ks + hi) ^ vsw) << 3, ub = ((4 * ks + 2 + hi) ^ vsw) << 3;
              const s16x4 a0 = *(const LAS s16x4*)(Vb + ua), a1 = *(const LAS s16x4*)(Vb + ub);
              const s16x4 b0 = *(const LAS s16x4*)(Vb + 4096 + ua), b1 = *(const LAS s16x4*)(Vb + 4096 + ub);
              const bf16x8 va = __builtin_shufflevector(a0, a1, 0, 1, 2, 3, 4, 5, 6, 7), vb = __builtin_shufflevector(b0, b1, 0, 1, 2, 3, 4, 5, 6, 7);
              o0 = MFMA32(va, pf[ks], o0); o1 = MFMA32(vb, pf[ks], o1); } }
    }
    lrun += __shfl_xor(lrun, 32);
    const float rl = 1.0f / lrun;
    GAS bf16* orow = MIX + (rb + q) * DM + 512 + h8 * 64 + 4 * hi;
#pragma unroll
    for (int g = 0; g < 4; ++g) {
        v2u a; a.x = pk2(o0[4 * g] * rl, o0[4 * g + 1] * rl); a.y = pk2(o0[4 * g + 2] * rl, o0[4 * g + 3] * rl); *(GAS v2u*)(orow + 8 * g) = a;
        v2u c; c.x = pk2(o1[4 * g] * rl, o1[4 * g + 1] * rl); c.y = pk2(o1[4 * g + 2] * rl, o1[4 * g + 3] * rl); *(GAS v2u*)(orow + 32 + 8 * g) = c;
    }
    __syncthreads();
}
__device__ __forceinline__ void phase_attn(const Frame& F) {
    { LAS float* bt = (LAS float*)(F.lds + 32768); const GAS float* rbias = INP(F, IN_RELB);
      const int th[16] = {16, 19, 21, 24, 27, 31, 35, 40, 46, 52, 59, 67, 77, 87, 99, 113};
      for (int i = F.tid; i < 8 * 128; i += NTHREADS) { const int h = i >> 7, d = i & 127; int bk = d;
          if (d >= 16) { bk = 15;
#pragma unroll
              for (int k = 0; k < 16; ++k) bk += (d >= th[k]) ? 1 : 0; }
          bt[i] = rbias[h * 32 + bk] * LOG2E; }
      __syncthreads(); }
    for (int pi = F.vcu; pi < 256; pi += F.G) { const int bh = pi >> 3, s = pi & 7; attn_unit(F, bh >> 3, bh & 7, s); attn_unit(F, bh >> 3, bh & 7, 15 - s); }
}

constexpr int NPHASES = 1 + 9 * DEPTH;
#ifndef PH_MASK
#define PH_MASK 0x3ff
#endif
#define PHM(k) ((PH_MASK >> (k)) & 1)
#ifndef SEAM_TWICE
#define SEAM_TWICE 0
#endif
#ifndef MK_ONE_LAUNCH
#define MK_ONE_LAUNCH 1
#endif
__device__ __forceinline__ Frame relaunder(const Frame& F0) {
    Frame F = F0; int t; asm volatile("v_mbcnt_lo_u32_b32 %0, -1, 0\n\tv_mbcnt_hi_u32_b32 %0, -1, %0\n\tv_lshl_add_u32 %0, %1, 6, %0" : "=&v"(t) : "s"(F0.wave)); F.tid = t; F.lane = t & 63; F.wave = __builtin_amdgcn_readfirstlane(t >> 6);
    asm volatile("" : "+s"(F.ws)); asm volatile("" : "+s"(F.X)); asm volatile("" : "+s"(F.G)); asm volatile("" : "+s"(F.vcu)); asm volatile("" : "+s"(F.bx));
    return F; }
__global__ void __launch_bounds__(NTHREADS, 2) fwd(Args args) {
    extern __shared__ __attribute__((aligned(16))) unsigned char lds_raw[];
    Frame F;
    F.lds = (LAS unsigned char*)lds_raw;
    F.tid = threadIdx.x; F.lane = F.tid & 63; F.wave = __builtin_amdgcn_readfirstlane(F.tid >> 6);
    F.G = gridDim.x; F.bx = blockIdx.x; { const int bx = blockIdx.x; F.vcu = (F.G % 8 == 0) ? (bx % 8) * (F.G / 8) + bx / 8 : bx; }
    F.in = args.in; F.X = (GAS float*)args.out; F.ws = (GAS unsigned char*)args.ws;
    if (F.tid < 4) ((LAS unsigned*)(F.lds + MISC_OFF))[F.tid] = 0u;
    __syncthreads();
    const int lo = args.ph_lo, hi = args.ph_hi;
    if (hi - lo > 1) (void)xcd_barrier_post((unsigned*)(args.ws + WS_CTL), (volatile LAS unsigned*)(F.lds + MISC_OFF));
#define IN(k) (lo <= (k) && (k) < hi)
#define XBAR() do { GAS unsigned char* wsb = (GAS unsigned char*)args.ws; asm volatile("" : "+s"(wsb)); XcdBarrier b_; b_.bar = (unsigned*)(wsb + WS_CTL); b_.x = xb_xcc_id(); b_.st = (volatile LAS unsigned*)(F.lds + MISC_OFF); xcd_barrier(b_); } while (0)
#define SEAM(k) do { if (IN(k) && IN((k) + 1)) { GAS unsigned char* wsb = (GAS unsigned char*)args.ws; asm volatile("" : "+s"(wsb)); XcdBarrier b_; b_.bar = (unsigned*)(wsb + WS_CTL); b_.x = xb_xcc_id(); b_.st = (volatile LAS unsigned*)(F.lds + MISC_OFF); xcd_barrier(b_); if (SEAM_TWICE) xcd_barrier(b_); } } while (0)
    GAS unsigned char* const ws = (GAS unsigned char*)args.ws;
    if (PHM(0) && IN(0)) { const Frame Fl = relaunder(F); phase_prologue(Fl); }
    SEAM(0);

    { constexpr int L = 0;
    {
        const int p0 = 1 + 9 * L;
        GAS unsigned char* wl = ws + WS_W + (size_t)L * LW_BYTES;
        if (PHM(1) && IN(p0 + 0)) {
            const Frame Fl = relaunder(F); GAS unsigned char* const wsl = Fl.ws; GAS unsigned char* const wll = wsl + WS_W + (size_t)L * LW_BYTES; pg8::Gemm g{(const pg8::bf16_t*)(wsl + WS_XB), (const pg8::bf16_t*)(wll + LW_WIN), M, ZP, DM}; pg8::StaticOrder S; S.init(M, ZP, Fl.G, Fl.bx);
            EpiZ E{(GAS bf16*)(wsl + WS_RZ), (const GAS float*)(wsl + WS_RSSPX)};
            pg8::gemm_phase<EpiZ, pg8::StaticOrder, true, true>(F.lds, g, S, E, Fl.tid);
        }
        SEAM(p0 + 0);
        if (PHM(2) && IN(p0 + 1)) { const Frame Fl = relaunder(F); phase_index(Fl); }
        if (PHM(2) && IN(p0 + 1)) { const Frame Fl = relaunder(F); phase_prep(Fl, L); }
        SEAM(p0 + 1);
        if (PHM(3) && IN(p0 + 2)) { const Frame Fl = relaunder(F); phase_attn(Fl); }
        SEAM(p0 + 2);
        if (PHM(4) && IN(p0 + 3)) {
            const Frame Fl = relaunder(F); GAS unsigned char* const wsl = Fl.ws; GAS unsigned char* const wll = wsl + WS_W + (size_t)L * LW_BYTES; pg8::Gemm g{(const pg8::bf16_t*)(wsl + WS_RM), (const pg8::bf16_t*)(wll + LW_WOUT), M, DM, DM}; pg8::StaticOrder S; S.init(M, DM, Fl.G, Fl.bx);
            EpiT E{(GAS bf16*)(wsl + WS_RZ), (GAS float*)(wsl + WS_RSSPT)};
            pg8::gemm_phase<EpiT, pg8::StaticOrder, true, true>(F.lds, g, S, E, Fl.tid);
        }
        SEAM(p0 + 3);
        if (PHM(5) && IN(p0 + 4)) { const Frame Fl = relaunder(F); phase_resid(Fl, (const GAS bf16*)(Fl.ws + WS_RZ), (const GAS float*)(Fl.ws + WS_RSSPT), INP(Fl, IN_GMIXPOST) + L * DM); }
        SEAM(p0 + 4);
        if (PHM(6) && IN(p0 + 5)) {
            const Frame Fl = relaunder(F); GAS unsigned char* const wsl = Fl.ws; GAS unsigned char* const wll = wsl + WS_W + (size_t)L * LW_BYTES; pg8::Gemm g{(const pg8::bf16_t*)(wsl + WS_XB), (const pg8::bf16_t*)(wll + LW_WGU), M, 2 * DFF, DM}; pg8::StaticOrder S; S.init(M, 2 * DFF, Fl.G, Fl.bx);
            EpiSwiGLU E{(GAS bf16*)(wsl + WS_RZ), (const GAS float*)(wsl + WS_RSS1)};
            pg8::gemm_phase<EpiSwiGLU, pg8::StaticOrder, true, true>(F.lds, g, S, E, Fl.tid);
            if ((int)blockIdx.x >= F.G / 2) {
                __syncthreads();
            { const Frame Fl = relaunder(F); GAS unsigned char* const wsl = Fl.ws; GAS unsigned char* const wll = wsl + WS_W + (size_t)L * LW_BYTES; pg8::Gemm g{(const pg8::bf16_t*)(wsl + WS_PB) + (size_t)L * M * PLE, (const pg8::bf16_t*)(wll + LW_WP), M, DM, PLE}; pg8::StaticOrder S; S.init(M, DM, Fl.G / 2, Fl.bx - Fl.G / 2);
              EpiB E{(GAS bf16*)(wsl + WS_RV)};
              pg8::gemm_phase<EpiB, pg8::StaticOrder, false, false>(F.lds, g, S, E, Fl.tid); }
            }
        }
        SEAM(p0 + 5);
        if (PHM(7) && IN(p0 + 6)) {
            { const Frame Fl = relaunder(F); GAS unsigned char* const wsl = Fl.ws; GAS unsigned char* const wll = wsl + WS_W + (size_t)L * LW_BYTES; pg8::Gemm g{(const pg8::bf16_t*)(wsl + WS_RZ), (const pg8::bf16_t*)(wll + LW_WD), M, DM, DFF}; pg8::StaticOrder S; S.init(M, DM, Fl.G, Fl.bx);
              EpiT E{(GAS bf16*)(wsl + WS_RM), (GAS float*)(wsl + WS_RSSPT)};
              pg8::gemm_phase<EpiT, pg8::StaticOrder, true, true>(F.lds, g, S, E, Fl.tid); }
        }
        SEAM(p0 + 6);
        if (PHM(8) && IN(p0 + 7)) { const Frame Fl = relaunder(F); phase_resid(Fl, (const GAS bf16*)(Fl.ws + WS_RM), (const GAS float*)(Fl.ws + WS_RSSPT), INP(Fl, IN_GFFNPOST) + L * DM); }
        SEAM(p0 + 7);
        if (PHM(9) && IN(p0 + 8)) {
            const Frame Fl = relaunder(F); GAS unsigned char* const wsl = Fl.ws; GAS unsigned char* const wll = wsl + WS_W + (size_t)L * LW_BYTES; pg8::Gemm g{(const pg8::bf16_t*)(wsl + WS_XB), (const pg8::bf16_t*)(wll + LW_WG), M, DM, DM}; pg8::StaticOrder S; S.init(M, DM, Fl.G, Fl.bx);
            EpiPLE E{Fl.X, (GAS bf16*)(wsl + WS_XB), (const GAS bf16*)(wsl + WS_RV), (const GAS float*)(wsl + WS_RSS1), (GAS float*)(wsl + WS_RSSPX)};
            pg8::gemm_phase<EpiPLE, pg8::StaticOrder, true, true>(F.lds, g, S, E, Fl.tid);
        }
        SEAM(p0 + 8);
    }
        }

    { constexpr int L = 1;
    {
        const int p0 = 1 + 9 * L;
        GAS unsigned char* wl = ws + WS_W + (size_t)L * LW_BYTES;
        if (PHM(1) && IN(p0 + 0)) {
            const Frame Fl = relaunder(F); GAS unsigned char* const wsl = Fl.ws; GAS unsigned char* const wll = wsl + WS_W + (size_t)L * LW_BYTES; pg8::Gemm g{(const pg8::bf16_t*)(wsl + WS_XB), (const pg8::bf16_t*)(wll + LW_WIN), M, ZP, DM}; pg8::StaticOrder S; S.init(M, ZP, Fl.G, Fl.bx);
            EpiZ E{(GAS bf16*)(wsl + WS_RZ), (const GAS float*)(wsl + WS_RSSPX)};
            pg8::gemm_phase<EpiZ, pg8::StaticOrder, true, true>(F.lds, g, S, E, Fl.tid);
        }
        SEAM(p0 + 0);
        if (PHM(2) && IN(p0 + 1)) { const Frame Fl = relaunder(F); phase_index(Fl); }
        if (PHM(2) && IN(p0 + 1)) { const Frame Fl = relaunder(F); phase_prep(Fl, L); }
        SEAM(p0 + 1);
        if (PHM(3) && IN(p0 + 2)) { const Frame Fl = relaunder(F); phase_attn(Fl); }
        SEAM(p0 + 2);
        if (PHM(4) && IN(p0 + 3)) {
            const Frame Fl = relaunder(F); GAS unsigned char* const wsl = Fl.ws; GAS unsigned char* const wll = wsl + WS_W + (size_t)L * LW_BYTES; pg8::Gemm g{(const pg8::bf16_t*)(wsl + WS_RM), (const pg8::bf16_t*)(wll + LW_WOUT), M, DM, DM}; pg8::StaticOrder S; S.init(M, DM, Fl.G, Fl.bx);
            EpiT E{(GAS bf16*)(wsl + WS_RZ), (GAS float*)(wsl + WS_RSSPT)};
            pg8::gemm_phase<EpiT, pg8::StaticOrder, true, true>(F.lds, g, S, E, Fl.tid);
        }
        SEAM(p0 + 3);
        if (PHM(5) && IN(p0 + 4)) { const Frame Fl = relaunder(F); phase_resid(Fl, (const GAS bf16*)(Fl.ws + WS_RZ), (const GAS float*)(Fl.ws + WS_RSSPT), INP(Fl, IN_GMIXPOST) + L * DM); }
        SEAM(p0 + 4);
        if (PHM(6) && IN(p0 + 5)) {
            const Frame Fl = relaunder(F); GAS unsigned char* const wsl = Fl.ws; GAS unsigned char* const wll = wsl + WS_W + (size_t)L * LW_BYTES; pg8::Gemm g{(const pg8::bf16_t*)(wsl + WS_XB), (const pg8::bf16_t*)(wll + LW_WGU), M, 2 * DFF, DM}; pg8::StaticOrder S; S.init(M, 2 * DFF, Fl.G, Fl.bx);
            EpiSwiGLU E{(GAS bf16*)(wsl + WS_RZ), (const GAS float*)(wsl + WS_RSS1)};
            pg8::gemm_phase<EpiSwiGLU, pg8::StaticOrder, true, true>(F.lds, g, S, E, Fl.tid);
            if ((int)blockIdx.x >= F.G / 2) {
                __syncthreads();
            { const Frame Fl = relaunder(F); GAS unsigned char* const wsl = Fl.ws; GAS unsigned char* const wll = wsl + WS_W + (size_t)L * LW_BYTES; pg8::Gemm g{(const pg8::bf16_t*)(wsl + WS_PB) + (size_t)L * M * PLE, (const pg8::bf16_t*)(wll + LW_WP), M, DM, PLE}; pg8::StaticOrder S; S.init(M, DM, Fl.G / 2, Fl.bx - Fl.G / 2);
              EpiB E{(GAS bf16*)(wsl + WS_RV)};
              pg8::gemm_phase<EpiB, pg8::StaticOrder, false, false>(F.lds, g, S, E, Fl.tid); }
            }
        }
        SEAM(p0 + 5);
        if (PHM(7) && IN(p0 + 6)) {
            { const Frame Fl = relaunder(F); GAS unsigned char* const wsl = Fl.ws; GAS unsigned char* const wll = wsl + WS_W + (size_t)L * LW_BYTES; pg8::Gemm g{(const pg8::bf16_t*)(wsl + WS_RZ), (const pg8::bf16_t*)(wll + LW_WD), M, DM, DFF}; pg8::StaticOrder S; S.init(M, DM, Fl.G, Fl.bx);
              EpiT E{(GAS bf16*)(wsl + WS_RM), (GAS float*)(wsl + WS_RSSPT)};
              pg8::gemm_phase<EpiT, pg8::StaticOrder, true, true>(F.lds, g, S, E, Fl.tid); }
        }
        SEAM(p0 + 6);
        if (PHM(8) && IN(p0 + 7)) { const Frame Fl = relaunder(F); phase_resid(Fl, (const GAS bf16*)(Fl.ws + WS_RM), (const GAS float*)(Fl.ws + WS_RSSPT), INP(Fl, IN_GFFNPOST) + L * DM); }
        SEAM(p0 + 7);
        if (PHM(9) && IN(p0 + 8)) {
            const Frame Fl = relaunder(F); GAS unsigned char* const wsl = Fl.ws; GAS unsigned char* const wll = wsl + WS_W + (size_t)L * LW_BYTES; pg8::Gemm g{(const pg8::bf16_t*)(wsl + WS_XB), (const pg8::bf16_t*)(wll + LW_WG), M, DM, DM}; pg8::StaticOrder S; S.init(M, DM, Fl.G, Fl.bx);
            EpiPLE E{Fl.X, (GAS bf16*)(wsl + WS_XB), (const GAS bf16*)(wsl + WS_RV), (const GAS float*)(wsl + WS_RSS1), (GAS float*)(wsl + WS_RSSPX)};
            pg8::gemm_phase<EpiPLE, pg8::StaticOrder, true, true>(F.lds, g, S, E, Fl.tid);
        }
        SEAM(p0 + 8);
    }
        }

    { constexpr int L = 2;
    {
        const int p0 = 1 + 9 * L;
        GAS unsigned char* wl = ws + WS_W + (size_t)L * LW_BYTES;
        if (PHM(1) && IN(p0 + 0)) {
            const Frame Fl = relaunder(F); GAS unsigned char* const wsl = Fl.ws; GAS unsigned char* const wll = wsl + WS_W + (size_t)L * LW_BYTES; pg8::Gemm g{(const pg8::bf16_t*)(wsl + WS_XB), (const pg8::bf16_t*)(wll + LW_WIN), M, ZP, DM}; pg8::StaticOrder S; S.init(M, ZP, Fl.G, Fl.bx);
            EpiZ E{(GAS bf16*)(wsl + WS_RZ), (const GAS float*)(wsl + WS_RSSPX)};
            pg8::gemm_phase<EpiZ, pg8::StaticOrder, true, true>(F.lds, g, S, E, Fl.tid);
        }
        SEAM(p0 + 0);
        if (PHM(2) && IN(p0 + 1)) { const Frame Fl = relaunder(F); phase_index(Fl); }
        if (PHM(2) && IN(p0 + 1)) { const Frame Fl = relaunder(F); phase_prep(Fl, L); }
        SEAM(p0 + 1);
        if (PHM(3) && IN(p0 + 2)) { const Frame Fl = relaunder(F); phase_attn(Fl); }
        SEAM(p0 + 2);
        if (PHM(4) && IN(p0 + 3)) {
            const Frame Fl = relaunder(F); GAS unsigned char* const wsl = Fl.ws; GAS unsigned char* const wll = wsl + WS_W + (size_t)L * LW_BYTES; pg8::Gemm g{(const pg8::bf16_t*)(wsl + WS_RM), (const pg8::bf16_t*)(wll + LW_WOUT), M, DM, DM}; pg8::StaticOrder S; S.init(M, DM, Fl.G, Fl.bx);
            EpiT E{(GAS bf16*)(wsl + WS_RZ), (GAS float*)(wsl + WS_RSSPT)};
            pg8::gemm_phase<EpiT, pg8::StaticOrder, true, true>(F.lds, g, S, E, Fl.tid);
        }
        SEAM(p0 + 3);
        if (PHM(5) && IN(p0 + 4)) { const Frame Fl = relaunder(F); phase_resid(Fl, (const GAS bf16*)(Fl.ws + WS_RZ), (const GAS float*)(Fl.ws + WS_RSSPT), INP(Fl, IN_GMIXPOST) + L * DM); }
        SEAM(p0 + 4);
        if (PHM(6) && IN(p0 + 5)) {
            const Frame Fl = relaunder(F); GAS unsigned char* const wsl = Fl.ws; GAS unsigned char* const wll = wsl + WS_W + (size_t)L * LW_BYTES; pg8::Gemm g{(const pg8::bf16_t*)(wsl + WS_XB), (const pg8::bf16_t*)(wll + LW_WGU), M, 2 * DFF, DM}; pg8::StaticOrder S; S.init(M, 2 * DFF, Fl.G, Fl.bx);
            EpiSwiGLU E{(GAS bf16*)(wsl + WS_RZ), (const GAS float*)(wsl + WS_RSS1)};
            pg8::gemm_phase<EpiSwiGLU, pg8::StaticOrder, true, true>(F.lds, g, S, E, Fl.tid);
            if ((int)blockIdx.x >= F.G / 2) {
                __syncthreads();
            { const Frame Fl = relaunder(F); GAS unsigned char* const wsl = Fl.ws; GAS unsigned char* const wll = wsl + WS_W + (size_t)L * LW_BYTES; pg8::Gemm g{(const pg8::bf16_t*)(wsl + WS_PB) + (size_t)L * M * PLE, (const pg8::bf16_t*)(wll + LW_WP), M, DM, PLE}; pg8::StaticOrder S; S.init(M, DM, Fl.G / 2, Fl.bx - Fl.G / 2);
              EpiB E{(GAS bf16*)(wsl + WS_RV)};
              pg8::gemm_phase<EpiB, pg8::StaticOrder, false, false>(F.lds, g, S, E, Fl.tid); }
            }
        }
        SEAM(p0 + 5);
        if (PHM(7) && IN(p0 + 6)) {
            { const Frame Fl = relaunder(F); GAS unsigned char* const wsl = Fl.ws; GAS unsigned char* const wll = wsl + WS_W + (size_t)L * LW_BYTES; pg8::Gemm g{(const pg8::bf16_t*)(wsl + WS_RZ), (const pg8::bf16_t*)(wll + LW_WD), M, DM, DFF}; pg8::StaticOrder S; S.init(M, DM, Fl.G, Fl.bx);
              EpiT E{(GAS bf16*)(wsl + WS_RM), (GAS float*)(wsl + WS_RSSPT)};
              pg8::gemm_phase<EpiT, pg8::StaticOrder, true, true>(F.lds, g, S, E, Fl.tid); }
        }
        SEAM(p0 + 6);
        if (PHM(8) && IN(p0 + 7)) { const Frame Fl = relaunder(F); phase_resid(Fl, (const GAS bf16*)(Fl.ws + WS_RM), (const GAS float*)(Fl.ws + WS_RSSPT), INP(Fl, IN_GFFNPOST) + L * DM); }
        SEAM(p0 + 7);
        if (PHM(9) && IN(p0 + 8)) {
            const Frame Fl = relaunder(F); GAS unsigned char* const wsl = Fl.ws; GAS unsigned char* const wll = wsl + WS_W + (size_t)L * LW_BYTES; pg8::Gemm g{(const pg8::bf16_t*)(wsl + WS_XB), (const pg8::bf16_t*)(wll + LW_WG), M, DM, DM}; pg8::StaticOrder S; S.init(M, DM, Fl.G, Fl.bx);
            EpiPLE E{Fl.X, (GAS bf16*)(wsl + WS_XB), (const GAS bf16*)(wsl + WS_RV), (const GAS float*)(wsl + WS_RSS1), (GAS float*)(wsl + WS_RSSPX)};
            pg8::gemm_phase<EpiPLE, pg8::StaticOrder, true, true>(F.lds, g, S, E, Fl.tid);
        }
        SEAM(p0 + 8);
    }
        }

    { constexpr int L = 3;
    {
        const int p0 = 1 + 9 * L;
        GAS unsigned char* wl = ws + WS_W + (size_t)L * LW_BYTES;
        if (PHM(1) && IN(p0 + 0)) {
            const Frame Fl = relaunder(F); GAS unsigned char* const wsl = Fl.ws; GAS unsigned char* const wll = wsl + WS_W + (size_t)L * LW_BYTES; pg8::Gemm g{(const pg8::bf16_t*)(wsl + WS_XB), (const pg8::bf16_t*)(wll + LW_WIN), M, ZP, DM}; pg8::StaticOrder S; S.init(M, ZP, Fl.G, Fl.bx);
            EpiZ E{(GAS bf16*)(wsl + WS_RZ), (const GAS float*)(wsl + WS_RSSPX)};
            pg8::gemm_phase<EpiZ, pg8::StaticOrder, true, true>(F.lds, g, S, E, Fl.tid);
        }
        SEAM(p0 + 0);
        if (PHM(2) && IN(p0 + 1)) { const Frame Fl = relaunder(F); phase_index(Fl); }
        if (PHM(2) && IN(p0 + 1)) { const Frame Fl = relaunder(F); phase_prep(Fl, L); }
        SEAM(p0 + 1);
        if (PHM(3) && IN(p0 + 2)) { const Frame Fl = relaunder(F); phase_attn(Fl); }
        SEAM(p0 + 2);
        if (PHM(4) && IN(p0 + 3)) {
            const Frame Fl = relaunder(F); GAS unsigned char* const wsl = Fl.ws; GAS unsigned char* const wll = wsl + WS_W + (size_t)L * LW_BYTES; pg8::Gemm g{(const pg8::bf16_t*)(wsl + WS_RM), (const pg8::bf16_t*)(wll + LW_WOUT), M, DM, DM}; pg8::StaticOrder S; S.init(M, DM, Fl.G, Fl.bx);
            EpiT E{(GAS bf16*)(wsl + WS_RZ), (GAS float*)(wsl + WS_RSSPT)};
            pg8::gemm_phase<EpiT, pg8::StaticOrder, true, true>(F.lds, g, S, E, Fl.tid);
        }
        SEAM(p0 + 3);
        if (PHM(5) && IN(p0 + 4)) { const Frame Fl = relaunder(F); phase_resid(Fl, (const GAS bf16*)(Fl.ws + WS_RZ), (const GAS float*)(Fl.ws + WS_RSSPT), INP(Fl, IN_GMIXPOST) + L * DM); }
        SEAM(p0 + 4);
        if (PHM(6) && IN(p0 + 5)) {
            const Frame Fl = relaunder(F); GAS unsigned char* const wsl = Fl.ws; GAS unsigned char* const wll = wsl + WS_W + (size_t)L * LW_BYTES; pg8::Gemm g{(const pg8::bf16_t*)(wsl + WS_XB), (const pg8::bf16_t*)(wll + LW_WGU), M, 2 * DFF, DM}; pg8::StaticOrder S; S.init(M, 2 * DFF, Fl.G, Fl.bx);
            EpiSwiGLU E{(GAS bf16*)(wsl + WS_RZ), (const GAS float*)(wsl + WS_RSS1)};
            pg8::gemm_phase<EpiSwiGLU, pg8::StaticOrder, true, true>(F.lds, g, S, E, Fl.tid);
            if ((int)blockIdx.x >= F.G / 2) {
                __syncthreads();
            { const Frame Fl = relaunder(F); GAS unsigned char* const wsl = Fl.ws; GAS unsigned char* const wll = wsl + WS_W + (size_t)L * LW_BYTES; pg8::Gemm g{(const pg8::bf16_t*)(wsl + WS_PB) + (size_t)L * M * PLE, (const pg8::bf16_t*)(wll + LW_WP), M, DM, PLE}; pg8::StaticOrder S; S.init(M, DM, Fl.G / 2, Fl.bx - Fl.G / 2);
              EpiB E{(GAS bf16*)(wsl + WS_RV)};
              pg8::gemm_phase<EpiB, pg8::StaticOrder, false, false>(F.lds, g, S, E, Fl.tid); }
            }
        }
        SEAM(p0 + 5);
        if (PHM(7) && IN(p0 + 6)) {
            { const Frame Fl = relaunder(F); GAS unsigned char* const wsl = Fl.ws; GAS unsigned char* const wll = wsl + WS_W + (size_t)L * LW_BYTES; pg8::Gemm g{(const pg8::bf16_t*)(wsl + WS_RZ), (const pg8::bf16_t*)(wll + LW_WD), M, DM, DFF}; pg8::StaticOrder S; S.init(M, DM, Fl.G, Fl.bx);
              EpiT E{(GAS bf16*)(wsl + WS_RM), (GAS float*)(wsl + WS_RSSPT)};
              pg8::gemm_phase<EpiT, pg8::StaticOrder, true, true>(F.lds, g, S, E, Fl.tid); }
        }
        SEAM(p0 + 6);
        if (PHM(8) && IN(p0 + 7)) { const Frame Fl = relaunder(F); phase_resid(Fl, (const GAS bf16*)(Fl.ws + WS_RM), (const GAS float*)(Fl.ws + WS_RSSPT), INP(Fl, IN_GFFNPOST) + L * DM); }
        SEAM(p0 + 7);
        if (PHM(9) && IN(p0 + 8)) {
            const Frame Fl = relaunder(F); GAS unsigned char* const wsl = Fl.ws; GAS unsigned char* const wll = wsl + WS_W + (size_t)L * LW_BYTES; pg8::Gemm g{(const pg8::bf16_t*)(wsl + WS_XB), (const pg8::bf16_t*)(wll + LW_WG), M, DM, DM}; pg8::StaticOrder S; S.init(M, DM, Fl.G, Fl.bx);
            EpiPLE E{Fl.X, (GAS bf16*)(wsl + WS_XB), (const GAS bf16*)(wsl + WS_RV), (const GAS float*)(wsl + WS_RSS1), (GAS float*)(wsl + WS_RSSPX)};
            pg8::gemm_phase<EpiPLE, pg8::StaticOrder, true, true>(F.lds, g, S, E, Fl.tid);
        }
        SEAM(p0 + 8);
    }
        }

#undef IN
#undef SEAM
}

extern "C" void kernel_launch(void* const* d_in, const int* in_sizes, int n_in, void* d_out, int out_size, void* d_ws, size_t ws_size, hipStream_t stream) {
    static int grid = 0;
    if (grid == 0) {
        if (n_in != 17 || in_sizes[0] != M * DM || out_size != M * DM || ws_size < WS_END) {
            fprintf(stderr, "kernel_launch: unexpected problem (n_in %d, in0 %d, out %d, ws %zu < %zu); nothing launched\n", n_in, n_in > 0 ? in_sizes[0] : -1, out_size, ws_size, (size_t)WS_END); grid = -1; return; }
        int dev = 0, cus = 0, per_cu = 0;
        if (hipGetDevice(&dev) != hipSuccess || hipDeviceGetAttribute(&cus, hipDeviceAttributeMultiprocessorCount, dev) != hipSuccess) { grid = -1; return; }
        if (hipFuncSetAttribute((const void*)fwd, hipFuncAttributeMaxDynamicSharedMemorySize, LDS_BYTES) != hipSuccess) { fprintf(stderr, "kernel_launch: hipFuncSetAttribute failed\n"); grid = -1; return; }
        if (hipOccupancyMaxActiveBlocksPerMultiprocessor(&per_cu, (const void*)fwd, NTHREADS, LDS_BYTES) != hipSuccess || per_cu < 1)
            fprintf(stderr, "kernel_launch: occupancy query reports %d workgroups per CU\n", per_cu);
        (void)hipGetLastError();
        grid = cus;
    }
    if (grid < 0) return;
    if (hipMemsetAsync((char*)d_ws + WS_CTL, 0, CTL_ZERO_BYTES, stream) != hipSuccess) return;
    Args a{};
    for (int i = 0; i < 17; ++i) a.in[i] = (const float*)d_in[i];
    a.out = (float*)d_out; a.ws = (unsigned char*)d_ws;
#if MK_ONE_LAUNCH
    a.ph_lo = 0; a.ph_hi = NPHASES;
    hipLaunchKernelGGL(fwd, dim3(grid), dim3(NTHREADS), LDS_BYTES, stream, a);
#else
    for (int p = 0; p < NPHASES; ++p) { a.ph_lo = p; a.ph_hi = p + 1; hipLaunchKernelGGL(fwd, dim3(grid), dim3(NTHREADS), LDS_BYTES, stream, a); }
#endif
}
```
